# Optimizing an MI355X kernel written in HIP

```python
import math
import jax, jax.numpy as jnp
from jax import lax
import numpy as np

D_MODEL = 1024
BATCH = 32
SEQ = 2048
DEPTH = 2

D_MIX = D_MODEL
SSM_WIDTH = D_MIX // 2
SSM_CH = 16
SSM_GROUPS = SSM_WIDTH // SSM_CH
SSM_STATE = 64
GM_WIDTH = D_MIX - SSM_WIDTH
GM_HEADS = 4
GM_HEAD_DIM = GM_WIDTH // GM_HEADS
GM_CHUNK = 128
D_FF = ((8 * D_MODEL // 3 + 127) // 128) * 128
IN_COLS = SSM_WIDTH + 2 * GM_WIDTH
EPS = 1e-6
DT_MIN = 1e-3
DT_MAX = 1e-1

kernel_name = "hybrid_s5_gmlp_macaron"


def rmsnorm(x, g):
    xf = x.astype(jnp.float32)
    y = xf * lax.rsqrt(jnp.mean(xf * xf, axis=-1, keepdims=True) + EPS)
    return (y * g.astype(jnp.float32)).astype(x.dtype)


def swiglu(h, w_in, w_out):
    gu = h @ w_in
    g, u = gu[..., :D_FF], gu[..., D_FF:]
    return (jax.nn.silu(g) * u) @ w_out


def s5_group(u, a_re, a_im, log_dt, b_re, b_im, c_re, c_im, d_skip, glu_w, glu_b):
    bsz, seq = u.shape[0], u.shape[1]
    f32 = jnp.float32
    ug = u.reshape(bsz, seq, SSM_GROUPS, SSM_CH).astype(f32)
    lam = lax.complex(a_re.astype(f32), a_im.astype(f32))
    dt = jnp.exp(log_dt.astype(f32))[:, None]
    lam_bar = jnp.exp(lam * dt)
    b_mat = lax.complex(b_re.astype(f32), b_im.astype(f32))
    b_bar = ((lam_bar - 1.0) / lam)[..., None] * b_mat
    bu = jnp.einsum('blgc,gpc->blgp', ug, b_bar)
    a_elems = jnp.broadcast_to(lam_bar, (seq, SSM_GROUPS, SSM_STATE))

    def combine(left, right):
        a_l, b_l = left
        a_r, b_r = right
        return a_r * a_l, a_r * b_l + b_r

    def scan_one(bu_b):
        _, h = lax.associative_scan(combine, (a_elems, bu_b), axis=0)
        return h

    h = jax.vmap(scan_one)(bu)
    c_mat = lax.complex(c_re.astype(f32), c_im.astype(f32))
    y = jnp.einsum('blgp,gcp->blgc', h, c_mat).real + d_skip.astype(f32) * ug
    y = jax.nn.gelu(y)
    z = jnp.einsum('blgc,gce->blge', y, glu_w.astype(f32)) + glu_b.astype(f32)
    out = z[..., :SSM_CH] * jax.nn.sigmoid(z[..., SSM_CH:])
    return out.reshape(bsz, seq, SSM_WIDTH).astype(u.dtype)


def gmlp_group(u, v, v_gain, w_s, b_s):
    bsz, seq = u.shape[0], u.shape[1]
    u = jax.nn.gelu(u)
    v = jax.nn.gelu(v).reshape(bsz, seq // GM_CHUNK, GM_CHUNK, GM_HEADS, GM_HEAD_DIM)
    v = rmsnorm(v, v_gain.reshape(GM_HEADS, GM_HEAD_DIM))
    mask = jnp.tril(jnp.ones((GM_CHUNK, GM_CHUNK), dtype=bool))
    ws = jnp.where(mask[None], w_s, jnp.zeros_like(w_s))
    s = jnp.einsum('hts,bnshd->bnthd', ws, v) + b_s.T[None, None, :, :, None]
    return u * s.reshape(bsz, seq, GM_WIDTH)


def setup_inputs(seed: int = 0) -> dict:
    key = jax.random.key(seed)
    ks = jax.random.split(key, 26)
    f32 = jnp.float32
    nrm = lambda k, shape, scale: scale * jax.random.normal(k, shape, f32)
    gain = lambda k, shape: 1.0 + 0.05 * jax.random.normal(k, shape, f32)
    n_idx = jnp.arange(SSM_STATE, dtype=f32)
    return {
        "x": jax.random.normal(ks[0], (BATCH, SEQ, D_MODEL), f32),
        "norm_ffn1": gain(ks[1], (DEPTH, D_MODEL)),
        "ffn1_w_in": nrm(ks[2], (DEPTH, D_MODEL, 2 * D_FF), D_MODEL ** -0.5),
        "ffn1_w_out": nrm(ks[3], (DEPTH, D_FF, D_MODEL), D_FF ** -0.5),
        "norm_mix": gain(ks[4], (DEPTH, D_MODEL)),
        "mix_w_in": nrm(ks[5], (DEPTH, D_MODEL, IN_COLS), D_MODEL ** -0.5),
        "ssm_a_re": -0.5 + nrm(ks[6], (DEPTH, SSM_GROUPS, SSM_STATE), 0.01),
        "ssm_a_im": math.pi * n_idx + nrm(ks[7], (DEPTH, SSM_GROUPS, SSM_STATE), 0.01),
        "ssm_log_dt": jax.random.uniform(ks[8], (DEPTH, SSM_GROUPS), f32,
                                         math.log(DT_MIN), math.log(DT_MAX)),
        "ssm_b_re": nrm(ks[9], (DEPTH, SSM_GROUPS, SSM_STATE, SSM_CH), (2 * SSM_CH) ** -0.5),
        "ssm_b_im": nrm(ks[10], (DEPTH, SSM_GROUPS, SSM_STATE, SSM_CH), (2 * SSM_CH) ** -0.5),
        "ssm_c_re": nrm(ks[11], (DEPTH, SSM_GROUPS, SSM_CH, SSM_STATE), (2 * SSM_STATE) ** -0.5),
        "ssm_c_im": nrm(ks[12], (DEPTH, SSM_GROUPS, SSM_CH, SSM_STATE), (2 * SSM_STATE) ** -0.5),
        "ssm_d": nrm(ks[13], (DEPTH, SSM_GROUPS, SSM_CH), 1.0),
        "ssm_glu_w": nrm(ks[14], (DEPTH, SSM_GROUPS, SSM_CH, 2 * SSM_CH), SSM_CH ** -0.5),
        "ssm_glu_b": nrm(ks[15], (DEPTH, SSM_GROUPS, 2 * SSM_CH), 0.02),
        "gm_v_gain": gain(ks[16], (DEPTH, GM_WIDTH)),
        "gm_w_s": nrm(ks[17], (DEPTH, GM_HEADS, GM_CHUNK, GM_CHUNK), 0.5 * GM_CHUNK ** -0.5),
        "gm_b_s": 1.0 + nrm(ks[18], (DEPTH, GM_HEADS, GM_CHUNK), 0.1),
        "gain_ssm_out": gain(ks[19], (DEPTH, SSM_WIDTH)),
        "gain_gm_out": gain(ks[20], (DEPTH, GM_WIDTH)),
        "mix_w_out": nrm(ks[21], (DEPTH, D_MIX, D_MODEL), D_MIX ** -0.5),
        "norm_ffn2": gain(ks[22], (DEPTH, D_MODEL)),
        "ffn2_w_in": nrm(ks[23], (DEPTH, D_MODEL, 2 * D_FF), D_MODEL ** -0.5),
        "ffn2_w_out": nrm(ks[24], (DEPTH, D_FF, D_MODEL), D_FF ** -0.5),
        "norm_final": gain(ks[25], (D_MODEL,)),
    }


def reference(x, norm_ffn1, ffn1_w_in, ffn1_w_out, norm_mix, mix_w_in,
              ssm_a_re, ssm_a_im, ssm_log_dt, ssm_b_re, ssm_b_im, ssm_c_re, ssm_c_im,
              ssm_d, ssm_glu_w, ssm_glu_b, gm_v_gain, gm_w_s, gm_b_s,
              gain_ssm_out, gain_gm_out, mix_w_out, norm_ffn2, ffn2_w_in, ffn2_w_out,
              norm_final):
    for l in range(DEPTH):
        x = x + 0.5 * swiglu(rmsnorm(x, norm_ffn1[l]), ffn1_w_in[l], ffn1_w_out[l])
        z = rmsnorm(x, norm_mix[l]) @ mix_w_in[l]
        u_ssm = z[..., :SSM_WIDTH]
        u_gm = z[..., SSM_WIDTH:SSM_WIDTH + GM_WIDTH]
        v_gm = z[..., SSM_WIDTH + GM_WIDTH:]
        y_ssm = s5_group(u_ssm, ssm_a_re[l], ssm_a_im[l], ssm_log_dt[l],
                         ssm_b_re[l], ssm_b_im[l], ssm_c_re[l], ssm_c_im[l],
                         ssm_d[l], ssm_glu_w[l], ssm_glu_b[l])
        y_gm = gmlp_group(u_gm, v_gm, gm_v_gain[l], gm_w_s[l], gm_b_s[l])
        y = jnp.concatenate([rmsnorm(y_ssm, gain_ssm_out[l]),
                             rmsnorm(y_gm, gain_gm_out[l])], axis=-1)
        x = x + y @ mix_w_out[l]
        x = x + 0.5 * swiglu(rmsnorm(x, norm_ffn2[l]), ffn2_w_in[l], ffn2_w_out[l])
    return rmsnorm(x, norm_final)
```

```cpp
#include <hip/hip_runtime.h>
#include <hip/hip_cooperative_groups.h>
#include <cstdio>
#include <cstdint>
namespace cg = cooperative_groups;

#ifndef MK_COOP
#define MK_COOP 1
#endif
#ifndef MK_MASK
#define MK_MASK 0xffff
#endif
#ifndef PROBE_DUP
#define PROBE_DUP 0
#endif
#ifndef PROBE_EPI
#define PROBE_EPI 0
#endif
#ifndef PROBE_E1VAR
#define PROBE_E1VAR 0
#endif
#ifndef MK_KROT
#define MK_KROT 0
#endif
#ifndef PROBE_P0
#define PROBE_P0 0
#endif
#ifndef MK_VCU
#define MK_VCU 0
#endif
#ifndef MK_E2REV
#define MK_E2REV 0
#endif
#ifndef PROBE_SYNC
#define PROBE_SYNC 0
#endif

#define LAS __attribute__((address_space(3)))
typedef unsigned short bf16_t;
typedef short bf16x8 __attribute__((ext_vector_type(8)));
typedef float f32x4 __attribute__((ext_vector_type(4)));
typedef float f32x2 __attribute__((ext_vector_type(2)));
typedef unsigned u32x4 __attribute__((ext_vector_type(4)));
typedef unsigned u32x2 __attribute__((ext_vector_type(2)));

constexpr int DM = 1024, NBATCH = 32, SEQ = 2048, MTOK = NBATCH * SEQ, DFF = 2816, NIN = 1536;
constexpr float EPS = 1e-6f;
constexpr int KSSM = 1152;

constexpr size_t SZ_XB = (size_t)MTOK * DM * 2;
constexpr size_t SZ_HID = (size_t)MTOK * DFF * 2;
constexpr size_t SZ_ASSM = (size_t)32768 * KSSM * 2;
constexpr size_t SZ_T512 = (size_t)MTOK * 512 * 2;
constexpr size_t OFF_XB = 0;
constexpr size_t OFF_HID = OFF_XB + SZ_XB;
constexpr size_t OFF_ASSM = OFF_HID;
constexpr size_t OFF_GU = OFF_ASSM + SZ_ASSM;
constexpr size_t OFF_GV = OFF_GU + SZ_T512;
constexpr size_t OFF_VT = OFF_GV + SZ_T512;
constexpr size_t OFF_YRAW = OFF_VT + SZ_T512;
constexpr size_t OFF_Y = OFF_GV;
static_assert(OFF_YRAW + SZ_T512 <= OFF_HID + SZ_HID, "mix buffers must fit in the hid region");
constexpr size_t OFF_YGM = OFF_HID + SZ_HID;
constexpr size_t OFF_W = OFF_YGM + SZ_T512;
constexpr size_t W_IN1 = 0, W_OUT1 = W_IN1 + (size_t)5632 * 1024 * 2, W_MI = W_OUT1 + (size_t)1024 * 2816 * 2,
                 W_MO = W_MI + (size_t)1536 * 1024 * 2, W_IN2 = W_MO + (size_t)1024 * 1024 * 2, W_OUT2 = W_IN2 + (size_t)5632 * 1024 * 2,
                 W_LAYER = W_OUT2 + (size_t)1024 * 2816 * 2;
constexpr size_t OFF_BSSM = OFF_W + 2 * W_LAYER;
constexpr size_t SZ_BSSM = (size_t)32 * 1024 * KSSM * 2;
constexpr size_t OFF_BST = OFF_BSSM + 2 * SZ_BSSM;
constexpr size_t SZ_BST = (size_t)32 * 256 * 1024 * 2;
constexpr size_t OFF_WEXP = OFF_BST + 2 * SZ_BST;
constexpr size_t SZ_WEXP = (size_t)4 * 256 * 256 * 2;
constexpr size_t OFF_SSQ = OFF_WEXP + 2 * SZ_WEXP;
constexpr size_t SZ_SSQ = (size_t)MTOK * 4 * 4;
constexpr size_t OFF_BAR = OFF_SSQ + SZ_SSQ;
constexpr size_t SZ_BAR = 16384;
constexpr size_t WS_END = OFF_BAR + SZ_BAR;

constexpr int LDS_SPARE = 131072;
constexpr int LDS_BARW = 131072 + 8192;
constexpr int LDS_BYTES = 131072 + 8192 + 64;

struct Params {
    const float* in[26];
    float* out;
    unsigned char* ws;
    int ph_lo, ph_hi;
};

__device__ __forceinline__ unsigned cvt_pk_bf16(float lo, float hi) { unsigned r; asm volatile("v_cvt_pk_bf16_f32 %0, %1, %2" : "=v"(r) : "v"(lo), "v"(hi)); return r; }
__device__ __forceinline__ float bf_lo(unsigned w) { return __uint_as_float(w << 16); }
__device__ __forceinline__ float bf_hi(unsigned w) { return __uint_as_float(w & 0xffff0000u); }
__device__ __forceinline__ float fast_sigmoid(float z) { return __builtin_amdgcn_rcpf(1.0f + __builtin_amdgcn_exp2f(-1.44269504f * z)); }
__device__ __forceinline__ float gelu_tanh(float x) {
    const float z = 1.5957691216f * (x + 0.044715f * x * x * x);
    return x * fast_sigmoid(z);
}
__device__ __forceinline__ float silu(float x) { return x * fast_sigmoid(x); }
__device__ __forceinline__ float shx(float v, int mask, int lane) { return __int_as_float(__builtin_amdgcn_ds_bpermute((lane ^ mask) << 2, __float_as_int(v))); }
__device__ __forceinline__ float wave_sum(float v, int lane) {
#pragma unroll
    for (int o = 1; o < 64; o <<= 1) v += shx(v, o, lane);
    return v;
}
__device__ __forceinline__ float rstd_from_ssq(const float* ssq, int row) {
    const f32x4 a = *(const f32x4*)(ssq + (size_t)row * 4);
    return __builtin_amdgcn_rsqf(((a.x + a.y) + (a.z + a.w)) * (1.0f / 1024.0f) + EPS);
}
__device__ __forceinline__ f32x2 lam_pow(float are, float aim, float dt, int k) {
    const float mag = __expf((float)k * dt * are);
    double rev = (double)k * (double)dt * (double)aim * 0.15915494309189535;
    rev -= __builtin_rint(rev);
    const float r = (float)rev;
    return (f32x2){mag * __builtin_amdgcn_cosf(r), mag * __builtin_amdgcn_sinf(r)};
}


#define XB_TMO      128
#define XB_XCNT(j)  (256  + 64 * (j))
#define XB_XSUB(j)  (1280 + 64 * (j))
#define XB_XGEN(j)  (2304 + 64 * (j))
#define XB_TOP      3328
#define XB_TOPGEN   3392
#define XCD_BAR_WORDS 3456
#define XB_VC(j)    (3584 + 64 * (j))
#define XB_SPIN_CAP (1u << 18)
__device__ __forceinline__ unsigned xb_ld(unsigned* p)              { return __hip_atomic_load(p, __ATOMIC_RELAXED, __HIP_MEMORY_SCOPE_AGENT); }
__device__ __forceinline__ unsigned xb_add(unsigned* p, unsigned v) { return __hip_atomic_fetch_add(p, v, __ATOMIC_RELAXED, __HIP_MEMORY_SCOPE_AGENT); }
__device__ __forceinline__ unsigned xb_xcc_id() { return (unsigned)__builtin_amdgcn_s_getreg((3 << 11) | 20) & 0xFu; }
#define XB_SPIN(cond, bar) do { unsigned _sp = 0; while (cond) { __builtin_amdgcn_s_sleep(1); \
    if ((++_sp & 255u) == 0u) { if (xb_ld(&(bar)[XB_TMO])) break; if (_sp > XB_SPIN_CAP) { atomicAdd(&(bar)[XB_TMO], 1u); break; } } } } while (0)
__device__ __forceinline__ void xcd_barrier_complete(unsigned* bar, unsigned x, unsigned& nloc, unsigned& nx) {
    const unsigned G = gridDim.x * gridDim.y * gridDim.z;
    unsigned sum, cnt, mine, sp = 0u;
    for (;;) {
        sum = 0u; cnt = 0u; mine = 0u;
#pragma unroll
        for (unsigned j = 0; j < 16; ++j) { const unsigned c = xb_ld(&bar[XB_XCNT(j)]); sum += c; cnt += (c > 0u) ? 1u : 0u; mine = (j == x) ? c : mine; }
        if (sum == G) break;
        __builtin_amdgcn_s_sleep(1);
        if ((++sp & 255u) == 0u) { if (xb_ld(&bar[XB_TMO])) break; if (sp > XB_SPIN_CAP) { atomicAdd(&bar[XB_TMO], 1u); break; } }
    }
    nloc = mine > 0u ? mine : 1u; nx = cnt > 0u ? cnt : 1u;
}
__device__ __forceinline__ void xcd_barrier(unsigned* bar, volatile LAS unsigned* st) {
    asm volatile("" : "+s"(bar));
    asm volatile("s_waitcnt vmcnt(0)" ::: "memory");
    __syncthreads();
    int t0 = threadIdx.x; asm volatile("" : "+v"(t0));
    if (t0 == 0) {
        __builtin_amdgcn_s_waitcnt(0);
        const unsigned x = xb_xcc_id();
        unsigned nloc = st[0], nx = st[1];
        if (nloc == 0u) { xcd_barrier_complete(bar, x, nloc, nx); st[0] = nloc; st[1] = nx; }
        const unsigned old = xb_add(&bar[XB_XSUB(x)], 1u);
        const unsigned gen = old / nloc;
        if (old + 1u == (gen + 1u) * nloc) {
            __builtin_amdgcn_fence(__ATOMIC_RELEASE, "agent");
            asm volatile("s_waitcnt vmcnt(0)" ::: "memory");
            const unsigned og = xb_add(&bar[XB_TOP], 1u);
            const unsigned tg = og / nx;
            if (og + 1u == (tg + 1u) * nx) xb_add(&bar[XB_TOPGEN], 1u);
            else XB_SPIN(xb_ld(&bar[XB_TOPGEN]) == tg, bar);
            __builtin_amdgcn_fence(__ATOMIC_ACQUIRE, "agent");
            xb_add(&bar[XB_XGEN(x)], 1u);
            asm volatile("s_waitcnt vmcnt(0)" ::: "memory");
        } else {
            XB_SPIN(xb_ld(&bar[XB_XGEN(x)]) == gen, bar);
            __builtin_amdgcn_fence(__ATOMIC_ACQUIRE, "agent");
            asm volatile("s_waitcnt vmcnt(0)" ::: "memory");
        }
    }
    __syncthreads();
}

namespace pg8 {
constexpr int BM = 256, BK = 64, HALF = 128, HTB = HALF * BK * 2, STAGE_BYTES = 8 * HTB, NXCD = 8, WGM = 8;
__host__ __device__ __forceinline__ int lds_byte(int r, int c) { const int st = (r >> 4) * 2 + (c >> 5), rr = r & 15, cc = c & 31, ob = rr * 64 + cc * 2; return st * 1024 + (ob ^ (((ob >> 9) & 1) << 5)); }
__host__ __device__ __forceinline__ void stage_rc(int b, int& R, int& C) { const int st = b / 1024, sb = b % 1024, swz = sb ^ (((sb >> 9) & 1) << 5); R = (st >> 1) * 16 + swz / 64; C = (st & 1) * 32 + (swz % 64) / 2; }
__host__ __device__ __forceinline__ int perm32(int rho) { const int n = rho >> 4, i = rho & 15; return 8 * (i >> 2) + 4 * n + (i & 3); }

struct Unit { int pm, pn, par, nt; };
struct Gemm { const bf16_t* A; const bf16_t* Bt; int lda, ldb, K, koff; };

struct StaticOrder {
    static constexpr bool VARK = false;
    int nM, nN, nwg, G, c, rev;
    __device__ void init(int M, int N, int G_, int c_, int rev_ = 0) { nM = M / BM; nN = N / BM; nwg = nM * nN; G = G_; c = c_; rev = rev_; }
    __device__ bool next(int i, Unit& u) const {
        const long L = (long)i * G + c; if (L >= nwg) return false;
        int wgid = (int)L; { const int q = nwg / NXCD, r = nwg % NXCD, xcd = wgid % NXCD, off = wgid / NXCD; wgid = (xcd < r ? xcd * (q + 1) : r * (q + 1) + (xcd - r) * q) + off; }
        const int nig = WGM * nN, gid = wgid / nig, fm = gid * WGM, gsz = (nM - fm) < WGM ? (nM - fm) : WGM;
        u.pm = (fm + ((wgid % nig) % gsz)) ^ rev; u.pn = (wgid % nig) / gsz; return true;
    }
};
struct OrderSsm {
    static constexpr bool VARK = true;
    int G, c;
    __device__ bool next(int i, Unit& u) const {
        const int cc = (i >> 1) * G + c; if (cc >= 256) return false;
        const int su = (G == 256) ? ((cc & 7) * 32 + (cc >> 3)) : cc;
        const int g = su >> 3, pml = (su >> 1) & 3, pair = su & 1, pnl = (i & 1) ? 3 - pair : pair;
        u.pm = 4 * g + pml; u.pn = 4 * g + pnl; u.nt = 2 + 4 * (pnl + 1); return true;
    }
};
struct OrderState {
    static constexpr bool VARK = false;
    int G, c;
    __device__ bool next(int i, Unit& u) const {
        const int L = i * G + c; if (L >= 128) return false;
        const int su = (G == 256) ? ((L & 7) * 16 + (L >> 3)) : L;
        const int g = su >> 2; u.pm = 4 * g + (su & 3); u.pn = g; return true;
    }
};
struct OrderSame { static constexpr bool VARK = false; int G, c, mode; StaticOrder so;
    __device__ bool next(int i, Unit& u) const { if (mode == 2) return so.next(i, u); if (i >= 22) return false; u.pm = 0; u.pn = 0; return true; }
};
struct OrderGm {
    static constexpr bool VARK = false;
    int G, c;
    __device__ bool next(int i, Unit& u) const { const int L = i * G + c; if (L >= 512) return false; u.pm = L >> 7; u.pn = L; return true; }
};

template <class Epi, class Sched, bool ALIGN_EPI = true, bool SP2 = true>
__device__ __forceinline__ void gemm_phase(LAS unsigned char* lds, const Gemm g, const Sched& S, const Epi& E) {
    int tid = threadIdx.x; asm volatile("" : "+v"(tid));
    const int wid = __builtin_amdgcn_readfirstlane(tid >> 6), lane = tid & 63, wr = wid >> 2, wc = wid & 3, fr = lane & 15, fq = lane >> 4;
    const int nt = g.K / BK;
    unsigned voffA[2], voffB[2];
#pragma unroll
    for (int i = 0; i < 2; ++i) { int R, C; stage_rc(tid * 16 + i * 8192, R, C); const int Rb = Epi::PERM ? ((R & ~31) + perm32(R & 31)) : R;
        voffA[i] = (unsigned)(R * g.lda + C) * 2u; voffB[i] = (unsigned)(Rb * g.ldb + C) * 2u; }
    const size_t kstep = (size_t)(BK * 2);
    const size_t hstepA = (size_t)HALF * g.lda * 2, hstepB = (size_t)HALF * g.ldb * 2;
    const size_t tstepA = 2 * hstepA, tstepB = 2 * hstepB;
    const unsigned ldsw = (unsigned)wid * 1024u;
    const int aoff = lds_byte(wr * 64 + fr, fq * 8), boff = lds_byte(wc * 32 + fr, fq * 8);
#define PG8_SA(b, h) (((b) * 2 + (h)) * HTB)
#define PG8_SB(b, h) ((4 + (b) * 2 + (h)) * HTB)
#define PG8_STAGE(bufoff, gbase, voff) do { _Pragma("unroll") for (int _i = 0; _i < 2; ++_i) \
        __builtin_amdgcn_global_load_lds((const unsigned*)((const char*)(gbase) + (voff)[_i]), (LAS unsigned*)(lds + (bufoff) + ldsw + _i * 8192), 16, 0, 0); } while (0)
#define PG8_LDA(dst, b, h) do { _Pragma("unroll") for (int m = 0; m < 4; ++m) _Pragma("unroll") for (int k = 0; k < 2; ++k) dst[m][k] = *(const LAS bf16x8*)(lds + PG8_SA(b, h) + aoff + m * 2048 + k * 1024); } while (0)
#define PG8_LDB(dst, b, h) do { _Pragma("unroll") for (int n = 0; n < 2; ++n) _Pragma("unroll") for (int k = 0; k < 2; ++k) dst[n][k] = *(const LAS bf16x8*)(lds + PG8_SB(b, h) + boff + n * 2048 + k * 1024); } while (0)
#define PG8_MMA(ai, bj, At, Bt) do { __builtin_amdgcn_s_setprio(1); _Pragma("unroll") for (int m = 0; m < 4; ++m) _Pragma("unroll") for (int n = 0; n < 2; ++n) _Pragma("unroll") for (int k = 0; k < 2; ++k) \
        acc[ai][bj][m][n] = __builtin_amdgcn_mfma_f32_16x16x32_bf16(Bt[n][k], At[m][k], acc[ai][bj][m][n], 0, 0, 0); __builtin_amdgcn_s_setprio(0); } while (0)
#define PG8_WAIT_V(n) asm volatile("s_waitcnt vmcnt(" #n ")" ::: "memory")
#define PG8_WAIT_L(n) asm volatile("s_waitcnt lgkmcnt(" #n ")" ::: "memory")
#define PG8_BAR __builtin_amdgcn_s_barrier()
#define PG8_SCHED __builtin_amdgcn_sched_barrier(0)
    Unit cur, nxt; int ui = 0;
    if (!S.next(0, cur)) return;
    cur.par = 0;
    f32x4 acc[2][2][4][2];
#pragma unroll
    for (int a = 0; a < 2; ++a)
#pragma unroll
        for (int b = 0; b < 2; ++b)
#pragma unroll
            for (int m = 0; m < 4; ++m)
#pragma unroll
                for (int n = 0; n < 2; ++n) acc[a][b][m][n] = (f32x4){0.f, 0.f, 0.f, 0.f};
    bf16x8 At[4][2], B0[2][2], B1[2][2];
    const char* cA = (const char*)g.A + (size_t)cur.pm * tstepA; const char* cB = (const char*)g.Bt + (size_t)cur.pn * tstepB;
    const size_t ko0 = (size_t)g.koff * kstep, kend = (size_t)nt * kstep;
    if constexpr (SP2) {
        PG8_STAGE(PG8_SB(0, 0), cB + ko0, voffB); PG8_STAGE(PG8_SB(0, 1), cB + ko0 + hstepB, voffB); PG8_STAGE(PG8_SA(0, 0), cA + ko0, voffA); PG8_STAGE(PG8_SA(0, 1), cA + ko0 + hstepA, voffA);
        if (wr == 1) PG8_BAR;
        PG8_WAIT_V(2); PG8_BAR;
        PG8_STAGE(PG8_SB(1, 0), cB + ko0 + kstep, voffB); PG8_STAGE(PG8_SA(1, 0), cA + ko0 + kstep, voffA); PG8_STAGE(PG8_SB(1, 1), cB + ko0 + hstepB + kstep, voffB);
        PG8_WAIT_V(6); PG8_BAR;
    } else {
        PG8_STAGE(PG8_SB(0, 0), cB, voffB); PG8_STAGE(PG8_SA(0, 0), cA, voffA); PG8_STAGE(PG8_SB(0, 1), cB + hstepB, voffB); PG8_STAGE(PG8_SA(0, 1), cA + hstepA, voffA);
        if (wr == 1) PG8_BAR;
        PG8_WAIT_V(4); PG8_BAR;
        PG8_STAGE(PG8_SB(1, 0), cB + kstep, voffB); PG8_STAGE(PG8_SA(1, 0), cA + kstep, voffA); PG8_STAGE(PG8_SB(1, 1), cB + hstepB + kstep, voffB);
        PG8_WAIT_V(6); PG8_BAR;
    }
    for (;;) {
        const bool has_next = S.next(ui + 1, nxt); nxt.par = (ui + 1) & 1;
        const char* nA = has_next ? (const char*)g.A + (size_t)nxt.pm * tstepA : cA; const char* nB = has_next ? (const char*)g.Bt + (size_t)nxt.pn * tstepB : cB;
        if constexpr (Epi::PRE) E.stage_pre(cur, lds, wid, lane);
        size_t ko = ko0;
        int unt = nt; if constexpr (Sched::VARK) unt = cur.nt;
        for (int t = 0; t < unt; t += 2) {
            const bool last = (t == unt - 2);
            size_t kn = ko + 2 * kstep; if (kn >= kend) kn -= kend;
            const char* a1 = cA + ko + kstep;
            const char* a2 = last ? nA + ko0 : cA + kn; const char* b2 = last ? nB + ko0 : cB + kn;
            const char* a3 = a2 + kstep; const char* b3 = b2 + kstep;
            ko = kn;
            if constexpr (SP2) {
            PG8_LDB(B0, 0, 0); PG8_LDB(B1, 0, 1); PG8_SCHED; PG8_LDA(At, 0, 0); PG8_STAGE(PG8_SA(1, 1), a1 + hstepA, voffA);
            PG8_WAIT_V(8); PG8_WAIT_L(0); PG8_BAR; PG8_MMA(0, 0, At, B0); PG8_MMA(0, 1, At, B1); PG8_BAR; PG8_SCHED;
            PG8_LDA(At, 0, 1); PG8_STAGE(PG8_SB(0, 0), b2, voffB); PG8_STAGE(PG8_SB(0, 1), b2 + hstepB, voffB); PG8_STAGE(PG8_SA(0, 0), a2, voffA);
            PG8_WAIT_V(8); PG8_WAIT_L(0); PG8_BAR; PG8_MMA(1, 0, At, B0); PG8_MMA(1, 1, At, B1); PG8_BAR; PG8_SCHED;
            PG8_LDB(B0, 1, 0); PG8_LDB(B1, 1, 1); PG8_SCHED; PG8_LDA(At, 1, 0); PG8_STAGE(PG8_SA(0, 1), a2 + hstepA, voffA);
            PG8_WAIT_V(8); PG8_WAIT_L(0); PG8_BAR; PG8_MMA(0, 0, At, B0); PG8_MMA(0, 1, At, B1); PG8_BAR; PG8_SCHED;
            PG8_LDA(At, 1, 1); PG8_STAGE(PG8_SB(1, 0), b3, voffB); PG8_STAGE(PG8_SB(1, 1), b3 + hstepB, voffB); PG8_STAGE(PG8_SA(1, 0), a3, voffA);
            PG8_WAIT_V(8); PG8_WAIT_L(0); PG8_BAR; PG8_MMA(1, 0, At, B0); PG8_MMA(1, 1, At, B1); PG8_BAR; PG8_SCHED;
            } else {
            PG8_LDB(B0, 0, 0); PG8_SCHED; PG8_LDA(At, 0, 0); PG8_STAGE(PG8_SA(1, 1), a1 + hstepA, voffA);
            PG8_WAIT_L(8); PG8_BAR; PG8_WAIT_L(0); PG8_MMA(0, 0, At, B0); PG8_BAR; PG8_SCHED;
            PG8_LDB(B1, 0, 1); PG8_STAGE(PG8_SB(0, 0), b2, voffB);
            PG8_BAR; PG8_WAIT_L(0); PG8_MMA(0, 1, At, B1); PG8_BAR;
            PG8_LDA(At, 0, 1); PG8_STAGE(PG8_SA(0, 0), a2, voffA);
            PG8_BAR; PG8_WAIT_L(0); PG8_MMA(1, 0, At, B0); PG8_BAR; PG8_SCHED;
            PG8_STAGE(PG8_SB(0, 1), b2 + hstepB, voffB);
            PG8_WAIT_V(6); PG8_BAR; PG8_MMA(1, 1, At, B1); PG8_BAR;
            PG8_LDB(B0, 1, 0); PG8_SCHED; PG8_LDA(At, 1, 0); PG8_STAGE(PG8_SA(0, 1), a2 + hstepA, voffA);
            PG8_WAIT_L(8); PG8_BAR; PG8_WAIT_L(0); PG8_MMA(0, 0, At, B0); PG8_BAR; PG8_SCHED;
            PG8_LDB(B1, 1, 1); PG8_STAGE(PG8_SB(1, 0), b3, voffB);
            PG8_BAR; PG8_WAIT_L(0); PG8_MMA(0, 1, At, B1); PG8_BAR;
            PG8_LDA(At, 1, 1); PG8_STAGE(PG8_SA(1, 0), a3, voffA);
            PG8_BAR; PG8_WAIT_L(0); PG8_MMA(1, 0, At, B0); PG8_BAR; PG8_SCHED;
            PG8_STAGE(PG8_SB(1, 1), b3 + hstepB, voffB);
            PG8_WAIT_V(6); PG8_BAR; PG8_MMA(1, 1, At, B1); PG8_BAR;
            }
        }
        if constexpr (ALIGN_EPI) { if (wr == 0) PG8_BAR; }
        if constexpr (!Epi::AFTER_DRAIN) { E(acc, cur, wr, wc, fr, fq); }
        if (!has_next) break;
#pragma unroll
        for (int a = 0; a < 2; ++a)
#pragma unroll
            for (int b = 0; b < 2; ++b)
#pragma unroll
                for (int m = 0; m < 4; ++m)
#pragma unroll
                    for (int n = 0; n < 2; ++n) acc[a][b][m][n] = (f32x4){0.f, 0.f, 0.f, 0.f};
        cur = nxt; cA = nA; cB = nB; ++ui;
        if constexpr (ALIGN_EPI) { if (wr == 1) PG8_BAR; }
    }
    PG8_WAIT_V(0);
    if constexpr (!ALIGN_EPI) { if (wr == 0) PG8_BAR; }
    PG8_BAR;
    if constexpr (Epi::AFTER_DRAIN) { E.fused(acc, cur, wr, wc, fr, fq, lds, wid, lane); }
#undef PG8_SA
#undef PG8_SB
#undef PG8_STAGE
#undef PG8_LDA
#undef PG8_LDB
#undef PG8_MMA
#undef PG8_WAIT_V
#undef PG8_WAIT_L
#undef PG8_BAR
#undef PG8_SCHED
}
}
using pg8::Unit;
typedef f32x4 AccT[2][2][4][2];


__device__ __forceinline__ void stage_ssq(const float* ssq, int pm, int par, LAS unsigned char* lds, int wid, int lane) {
    if (wid < 4) __builtin_amdgcn_global_load_lds((const unsigned*)(ssq + (size_t)(pm * 256 + wid * 64 + lane) * 4), (LAS unsigned*)(lds + LDS_SPARE + par * 4096 + wid * 1024), 16, 0, 0);
}
__device__ __forceinline__ float rstd_from_lds(LAS unsigned char* lds, int par, int rl) {
    const f32x4 a = *(const LAS f32x4*)(lds + LDS_SPARE + par * 4096 + rl * 16);
    return __builtin_amdgcn_rsqf(((a.x + a.y) + (a.z + a.w)) * (1.0f / 1024.0f) + EPS);
}
__device__ __forceinline__ f32x2 sigmoid2(f32x2 z) { const f32x2 t = z * -1.44269504f; f32x2 e; e.x = __builtin_amdgcn_exp2f(t.x); e.y = __builtin_amdgcn_exp2f(t.y); e = e + 1.0f; f32x2 r; r.x = __builtin_amdgcn_rcpf(e.x); r.y = __builtin_amdgcn_rcpf(e.y); return r; }
__device__ __forceinline__ f32x2 gelu2(f32x2 x) { const f32x2 z = (x * x * 0.044715f + 1.0f) * x * 1.5957691216f; return x * sigmoid2(z); }
struct EpiSwiglu {
    static constexpr bool PERM = true, AFTER_DRAIN = false, PRE = true;
    bf16_t* H; const float* ssq; LAS unsigned char* lds;
    __device__ __forceinline__ void stage_pre(const Unit& u, LAS unsigned char* l, int wid, int lane) const { stage_ssq(ssq, u.pm, u.par, l, wid, lane); }
    __device__ __forceinline__ void operator()(const AccT& acc, const Unit& u, int wr, int wc, int fr, int fq) const {
        const int rl0 = wr * 64 + fr, row0 = u.pm * 256 + rl0, col0 = u.pn * 128 + wc * 32 + 8 * fq;
        float rsv[8];
#pragma unroll
        for (int i = 0; i < 8; ++i) rsv[i] = rstd_from_lds(lds, u.par, rl0 + (i >> 2) * 128 + (i & 3) * 16);
#pragma unroll
        for (int ai = 0; ai < 2; ++ai)
#pragma unroll
            for (int m = 0; m < 4; ++m) {
                if (m == 0 && ai == 1) __builtin_amdgcn_sched_barrier(0);
                const int row = row0 + ai * 128 + m * 16;
                const float r = rsv[ai * 4 + m];
                unsigned w[4];
#pragma unroll
                for (int n = 0; n < 2; ++n)
#pragma unroll
                    for (int j = 0; j < 4; j += 2) {
                        const f32x2 g = (f32x2){acc[ai][0][m][n][j], acc[ai][0][m][n][j + 1]} * r, uu = (f32x2){acc[ai][1][m][n][j], acc[ai][1][m][n][j + 1]} * r;
                        const f32x2 h = g * uu * sigmoid2(g);
                        w[n * 2 + (j >> 1)] = cvt_pk_bf16(h.x, h.y);
                    }
                u32x4 wv; wv.x = w[0]; wv.y = w[1]; wv.z = w[2]; wv.w = w[3];
                *(u32x4*)(H + (size_t)row * DFF + col0) = wv;
            }
    }
};
struct EpiResid {
    static constexpr bool PERM = true, AFTER_DRAIN = false, PRE = false;
    bf16_t* xb; float* ssq; float alpha; LAS float* sp;
    __device__ __forceinline__ void operator()(const AccT& acc, const Unit& u, int wr, int wc, int fr, int fq) const {
        const int rl0 = wr * 64 + fr, row0 = u.pm * 256 + rl0, col0 = u.pn * 256 + wc * 32 + 8 * fq, ln = fr + 16 * fq;
        u32x4 xo[2][4][2];
#pragma unroll
        for (int ai = 0; ai < 2; ++ai)
#pragma unroll
            for (int m = 0; m < 4; ++m)
#pragma unroll
                for (int bj = 0; bj < 2; ++bj) xo[ai][m][bj] = *(const u32x4*)(xb + (size_t)(row0 + ai * 128 + m * 16) * DM + col0 + bj * 128);
        asm volatile("" ::: "memory");
#pragma unroll
        for (int ai = 0; ai < 2; ++ai) {
#pragma unroll
            for (int m = 0; m < 4; ++m) {
                float s = 0.f;
#pragma unroll
                for (int bj = 0; bj < 2; ++bj) {
                    const f32x4 a = acc[ai][bj][m][0], b = acc[ai][bj][m][1]; const u32x4 o = xo[ai][m][bj];
                    u32x4 w;
                    w.x = cvt_pk_bf16(bf_lo(o.x) + alpha * a.x, bf_hi(o.x) + alpha * a.y); w.y = cvt_pk_bf16(bf_lo(o.y) + alpha * a.z, bf_hi(o.y) + alpha * a.w);
                    w.z = cvt_pk_bf16(bf_lo(o.z) + alpha * b.x, bf_hi(o.z) + alpha * b.y); w.w = cvt_pk_bf16(bf_lo(o.w) + alpha * b.z, bf_hi(o.w) + alpha * b.w);
                    *(u32x4*)(xb + (size_t)(row0 + ai * 128 + m * 16) * DM + col0 + bj * 128) = w;
                    s += (bf_lo(w.x) * bf_lo(w.x) + bf_hi(w.x) * bf_hi(w.x)) + (bf_lo(w.y) * bf_lo(w.y) + bf_hi(w.y) * bf_hi(w.y))
                       + (bf_lo(w.z) * bf_lo(w.z) + bf_hi(w.z) * bf_hi(w.z)) + (bf_lo(w.w) * bf_lo(w.w) + bf_hi(w.w) * bf_hi(w.w));
                }
                s += shx(s, 16, ln); s += shx(s, 32, ln);
                if (fq == 0) sp[(ai * 128 + rl0 + m * 16) * 4 + wc] = s;
            }
        }
        asm volatile("s_waitcnt lgkmcnt(0)" ::: "memory"); __builtin_amdgcn_s_barrier(); asm volatile("" ::: "memory");
        const int t = wr * 256 + wc * 64 + ln;
        if (t < 256) { const f32x4 p = *(const LAS f32x4*)(sp + t * 4); ssq[(size_t)(u.pm * 256 + t) * 4 + u.pn] = (p.x + p.y) + (p.z + p.w); }
    }
};
struct EpiMixIn {
    static constexpr bool PERM = true, AFTER_DRAIN = false, PRE = true;
    bf16_t* Assm; bf16_t* gu; bf16_t* gv; const float* ssq; LAS unsigned char* lds;
    __device__ __forceinline__ void stage_pre(const Unit& u, LAS unsigned char* l, int wid, int lane) const { stage_ssq(ssq, u.pm, u.par, l, wid, lane); }
    __device__ __forceinline__ void operator()(const AccT& acc, const Unit& u, int wr, int wc, int fr, int fq) const {
        const int rl0 = wr * 64 + fr, row0 = u.pm * 256 + rl0, col0 = u.pn * 256 + wc * 32 + 8 * fq;
        float rsv[8];
#pragma unroll
        for (int i = 0; i < 8; ++i) rsv[i] = rstd_from_lds(lds, u.par, rl0 + (i >> 2) * 128 + (i & 3) * 16);
#pragma unroll
        for (int ai = 0; ai < 2; ++ai)
#pragma unroll
            for (int m = 0; m < 4; ++m) {
                if (m == 0) __builtin_amdgcn_sched_barrier(0);
                const int tok = row0 + ai * 128 + m * 16;
                const float rs = rsv[ai * 4 + m];
#pragma unroll
                for (int bj = 0; bj < 2; ++bj) {
                    const int j0 = col0 + bj * 128;
                    f32x2 v[4];
#pragma unroll
                    for (int n = 0; n < 2; ++n)
#pragma unroll
                        for (int j = 0; j < 2; ++j) v[n * 2 + j] = (f32x2){acc[ai][bj][m][n][2 * j], acc[ai][bj][m][n][2 * j + 1]} * rs;
                    bf16_t* dst;
                    if (u.pn < 2) {
                        const int g = j0 >> 4, c0 = j0 & 15, b = tok >> 11, l = tok & 2047;
                        dst = Assm + (size_t)(g * 1024 + b * 32 + (l >> 6)) * KSSM + 128 + (l & 63) * 16 + c0;
                    } else {
#pragma unroll
                        for (int j = 0; j < 4; ++j) v[j] = gelu2(v[j]);
                        dst = (u.pn < 4) ? gu + (size_t)tok * 512 + (j0 - 512) : gv + (size_t)tok * 512 + (j0 - 1024);
                    }
                    u32x4 w; w.x = cvt_pk_bf16(v[0].x, v[0].y); w.y = cvt_pk_bf16(v[1].x, v[1].y); w.z = cvt_pk_bf16(v[2].x, v[2].y); w.w = cvt_pk_bf16(v[3].x, v[3].y);
                    *(u32x4*)dst = w;
                }
            }
    }
};
struct EpiState {
    static constexpr bool PERM = false, AFTER_DRAIN = true, PRE = false;
    bf16_t* Assm; const float* are; const float* aim; const float* logdt;
    __device__ __forceinline__ void fused(const AccT& acc, const Unit& u, int wr, int wc, int fr, int fq, LAS unsigned char* lds, int wid, int lane) const {
        LAS float* T = (LAS float*)lds;
#pragma unroll
        for (int ai = 0; ai < 2; ++ai)
#pragma unroll
            for (int m = 0; m < 4; ++m)
#pragma unroll
                for (int n = 0; n < 2; ++n)
                    *(LAS f32x4*)(T + (ai * 128 + wr * 64 + m * 16 + fr) * 128 + wc * 32 + n * 16 + 4 * fq) = acc[ai][0][m][n];
        __syncthreads();
        const int g = u.pn, pml = u.pm & 3, bl = wid, p = lane;
        const float dt = __expf(logdt[g]);
        const f32x2 l64 = lam_pow(are[g * 64 + p], aim[g * 64 + p], dt, 64);
        float hr = 0.f, hi = 0.f;
        bf16_t* dst = Assm + (size_t)(g * 1024 + (8 * pml + bl) * 32) * KSSM + p;
        for (int ch = 0; ch < 32; ++ch) {
            dst[(size_t)ch * KSSM] = (bf16_t)(cvt_pk_bf16(hr, hr) & 0xffffu);
            dst[(size_t)ch * KSSM + 64] = (bf16_t)(cvt_pk_bf16(hi, hi) & 0xffffu);
            const float sr = T[(bl * 32 + ch) * 128 + p], si = T[(bl * 32 + ch) * 128 + 64 + p];
            const float nr = l64.x * hr - l64.y * hi + sr, ni = l64.x * hi + l64.y * hr + si;
            hr = nr; hi = ni;
        }
    }
};
struct EpiSsmY {
    static constexpr bool PERM = true, AFTER_DRAIN = false, PRE = false;
    bf16_t* yraw;
    __device__ __forceinline__ void operator()(const AccT& acc, const Unit& u, int wr, int wc, int fr, int fq) const {
        const int g = u.pn >> 2, pnl = u.pn & 3, pml = u.pm & 3;
#pragma unroll
        for (int ai = 0; ai < 2; ++ai)
#pragma unroll
            for (int m = 0; m < 4; ++m) {
                const int r = 256 * pml + 128 * ai + 64 * wr + 16 * m + fr;
#pragma unroll
                for (int bj = 0; bj < 2; ++bj) {
                    const int n0 = 256 * pnl + 128 * bj + 32 * wc + 8 * fq, tau = n0 >> 4, c0 = n0 & 15;
                    const f32x4 a = acc[ai][bj][m][0], b = acc[ai][bj][m][1];
                    u32x4 w; w.x = cvt_pk_bf16(a.x, a.y); w.y = cvt_pk_bf16(a.z, a.w); w.z = cvt_pk_bf16(b.x, b.y); w.w = cvt_pk_bf16(b.z, b.w);
                    *(u32x4*)(yraw + (size_t)(r * 64 + tau) * 512 + g * 16 + c0) = w;
                }
            }
    }
};
struct EpiGm {
    static constexpr bool PERM = true, AFTER_DRAIN = false, PRE = false;
    const bf16_t* gu; bf16_t* ygm; const float* vgain; const float* bs;
    __device__ __forceinline__ void operator()(const AccT& acc, const Unit& u, int wr, int wc, int fr, int fq) const {
        const int h = u.pm, q = u.pn & 127, d0 = 32 * wc + 8 * fq;
        const f32x4 g0 = *(const f32x4*)(vgain + h * 128 + d0), g1 = *(const f32x4*)(vgain + h * 128 + d0 + 4);
#pragma unroll
        for (int ai = 0; ai < 2; ++ai) {
            u32x4 uu[4][2]; float bb[4];
#pragma unroll
            for (int m = 0; m < 4; ++m) {
                const int t2 = 128 * ai + 64 * wr + 16 * m + fr;
                bb[m] = bs[h * 128 + (t2 & 127)];
#pragma unroll
                for (int bj = 0; bj < 2; ++bj) uu[m][bj] = *(const u32x4*)(gu + (size_t)((2 * q + bj) * 256 + t2) * 512 + h * 128 + d0);
            }
            asm volatile("" ::: "memory");
#pragma unroll
            for (int m = 0; m < 4; ++m) {
                const int t2 = 128 * ai + 64 * wr + 16 * m + fr;
                const float b = bb[m];
#pragma unroll
                for (int bj = 0; bj < 2; ++bj) {
                    const size_t o = (size_t)((2 * q + bj) * 256 + t2) * 512 + h * 128 + d0;
                    const u32x4 x = uu[m][bj];
                    const f32x4 a = acc[ai][bj][m][0] * g0 + b, c = acc[ai][bj][m][1] * g1 + b;
                    u32x4 w;
                    w.x = cvt_pk_bf16(bf_lo(x.x) * a.x, bf_hi(x.x) * a.y); w.y = cvt_pk_bf16(bf_lo(x.y) * a.z, bf_hi(x.y) * a.w);
                    w.z = cvt_pk_bf16(bf_lo(x.z) * c.x, bf_hi(x.z) * c.y); w.w = cvt_pk_bf16(bf_lo(x.w) * c.z, bf_hi(x.w) * c.w);
                    *(u32x4*)(ygm + o) = w;
                }
            }
            asm volatile("" ::: "memory");
        }
    }
};

__device__ __forceinline__ void p0_transpose_item(const float* W, int K, int N, bf16_t* WT, const float* gain, bool swi, LAS float* scr, int item, int lane) {
    const int nblk = N / 32, kb = item / nblk, nb = item % nblk, k0 = 64 * kb, n0 = 32 * nb;
    int s0 = n0;
    if (swi) { const int pn = n0 >> 8, r = n0 & 255; s0 = (r < 128) ? (128 * pn + r) : (DFF + 128 * pn + (r - 128)); }
    float tv[32];
#pragma unroll
    for (int i = 0; i < 32; ++i) tv[i] = W[(size_t)(k0 + 2 * i + (lane >> 5)) * N + s0 + (lane & 31)];
    if (gain) {
#pragma unroll
        for (int i = 0; i < 32; ++i) tv[i] *= gain[k0 + 2 * i + (lane >> 5)];
    }
#pragma unroll
    for (int i = 0; i < 32; ++i) scr[(2 * i + (lane >> 5)) * 33 + (lane & 31)] = tv[i];
    asm volatile("s_waitcnt lgkmcnt(0)" ::: "memory");
    const int c = lane & 7;
#pragma unroll
    for (int j = 0; j < 4; ++j) { const int n = (lane >> 3) + 8 * j; const LAS float* s = scr + (8 * c) * 33 + n;
        u32x4 o; o.x = cvt_pk_bf16(s[0 * 33], s[1 * 33]); o.y = cvt_pk_bf16(s[2 * 33], s[3 * 33]); o.z = cvt_pk_bf16(s[4 * 33], s[5 * 33]); o.w = cvt_pk_bf16(s[6 * 33], s[7 * 33]);
        *(u32x4*)(WT + (size_t)(n0 + n) * K + k0 + 8 * c) = o; }
    asm volatile("s_waitcnt lgkmcnt(0)" ::: "memory");
}

__device__ __forceinline__ void p0_ssm_item(const Params& P, int zoff, int item, LAS unsigned char* lds) {
    int tid = threadIdx.x; asm volatile("" : "+v"(tid));
    const int l = item >> 7, g = (item >> 2) & 31, q = item & 3, lg = l * 32 + g;
    LAS float* lam_re = (LAS float*)lds;
    LAS float* lam_im = lam_re + 65 * 64;
    LAS float* be_re = lam_im + 65 * 64;
    LAS float* be_im = be_re + 1024;
    LAS float* c_re = be_im + 1024;
    LAS float* c_im = c_re + 1024;
    LAS float* kt = c_im + 1024;
    const float* a_re = P.in[6 + zoff] + lg * 64; const float* a_im = P.in[7 + zoff] + lg * 64;
    const float dt = __expf(P.in[8 + zoff][lg]);
    for (int idx = tid; idx < 65 * 64; idx += 512) { const int k = idx >> 6, p = idx & 63; const f32x2 v = lam_pow(a_re[p], a_im[p], dt, k); lam_re[idx] = v.x; lam_im[idx] = v.y; }
    __syncthreads();
    for (int idx = tid; idx < 1024; idx += 512) {
        const int p = idx >> 4, c = idx & 15;
        const float lr = lam_re[64 + p] - 1.0f, li = lam_im[64 + p], ar = a_re[p], ai = a_im[p], inv = 1.0f / (ar * ar + ai * ai);
        const float qr = (lr * ar + li * ai) * inv, qi = (li * ar - lr * ai) * inv;
        const float br = P.in[9 + zoff][(size_t)(lg * 64 + p) * 16 + c], bi = P.in[10 + zoff][(size_t)(lg * 64 + p) * 16 + c];
        be_re[idx] = qr * br - qi * bi; be_im[idx] = qr * bi + qi * br;
        c_re[idx] = P.in[11 + zoff][(size_t)lg * 1024 + idx]; c_im[idx] = P.in[12 + zoff][(size_t)lg * 1024 + idx];
    }
    __syncthreads();
    for (int pr = tid; pr < 1024; pr += 512) {
        const int k = pr >> 4, c = pr & 15;
        float a[16];
#pragma unroll
        for (int j = 0; j < 16; ++j) a[j] = 0.f;
        for (int p = 0; p < 64; ++p) {
            const float cr = c_re[c * 64 + p], ci = c_im[c * 64 + p], lr = lam_re[k * 64 + p], li = lam_im[k * 64 + p];
            const float xr = cr * lr - ci * li, xi = cr * li + ci * lr;
#pragma unroll
            for (int j4 = 0; j4 < 4; ++j4) {
                const f32x4 br = *(const LAS f32x4*)(be_re + p * 16 + j4 * 4), bi = *(const LAS f32x4*)(be_im + p * 16 + j4 * 4);
#pragma unroll
                for (int j = 0; j < 4; ++j) a[j4 * 4 + j] += xr * br[j] - xi * bi[j];
            }
        }
        if (k == 0) {
            const float dsk = P.in[13 + zoff][lg * 16 + c];
#pragma unroll
            for (int j = 0; j < 16; ++j) if (j == c) a[j] += dsk;
        }
#pragma unroll
        for (int j = 0; j < 16; ++j) kt[pr * 16 + j] = a[j];
    }
    __syncthreads();
    bf16_t* Bs = (bf16_t*)(P.ws + OFF_BSSM + (size_t)l * SZ_BSSM) + (size_t)g * 1024 * KSSM;
    const int nvec = 16 + 2 * 16 * (q + 1);
    for (int idx = tid; idx < 256 * nvec; idx += 512) {
        const int n = 256 * q + idx / nvec, v = idx % nvec, tau = n >> 4, c = n & 15;
        float o[8];
        if (v >= 16) {
            const int s = (v - 16) >> 1, c0 = ((v - 16) & 1) * 8;
            if (s <= tau) {
                const LAS float* src = kt + ((tau - s) * 16 + c) * 16 + c0;
#pragma unroll
                for (int j = 0; j < 8; ++j) o[j] = src[j];
            } else {
#pragma unroll
                for (int j = 0; j < 8; ++j) o[j] = 0.f;
            }
        } else {
            const int j0 = v * 8;
#pragma unroll
            for (int j = 0; j < 8; ++j) {
                const int p = (j0 + j) & 63;
                const float cr = c_re[c * 64 + p], ci = c_im[c * 64 + p], lr = lam_re[(tau + 1) * 64 + p], li = lam_im[(tau + 1) * 64 + p];
                o[j] = (j0 < 64) ? (cr * lr - ci * li) : -(cr * li + ci * lr);
            }
        }
        u32x4 w; w.x = cvt_pk_bf16(o[0], o[1]); w.y = cvt_pk_bf16(o[2], o[3]); w.z = cvt_pk_bf16(o[4], o[5]); w.w = cvt_pk_bf16(o[6], o[7]);
        *(u32x4*)(Bs + (size_t)n * KSSM + v * 8) = w;
    }
    bf16_t* Bt = (bf16_t*)(P.ws + OFF_BST + (size_t)l * SZ_BST) + (size_t)g * 256 * 1024;
    for (int idx = tid; idx < 64 * 128; idx += 512) {
        const int r = 64 * q + (idx >> 7), v = idx & 127, s = v >> 1, c0 = (v & 1) * 8;
        float o[8];
        if (r < 128) {
            const int p = r & 63;
            const float lr = lam_re[(63 - s) * 64 + p], li = lam_im[(63 - s) * 64 + p];
#pragma unroll
            for (int j = 0; j < 8; ++j) { const float br = be_re[p * 16 + c0 + j], bi = be_im[p * 16 + c0 + j]; o[j] = (r < 64) ? (lr * br - li * bi) : (lr * bi + li * br); }
        } else {
#pragma unroll
            for (int j = 0; j < 8; ++j) o[j] = 0.f;
        }
        u32x4 w; w.x = cvt_pk_bf16(o[0], o[1]); w.y = cvt_pk_bf16(o[2], o[3]); w.z = cvt_pk_bf16(o[4], o[5]); w.w = cvt_pk_bf16(o[6], o[7]);
        *(u32x4*)(Bt + (size_t)r * 1024 + v * 8) = w;
    }
    __syncthreads();
}

__device__ __forceinline__ void phase0(const Params& P, int zoff, LAS unsigned char* lds, int c, int G) {
    int tid = threadIdx.x; asm volatile("" : "+v"(tid));
    const int lane = tid & 63, wave = tid >> 6;
    const bool ssm_first = (((c >> 3) & 1) == 0);
    if (ssm_first) { for (int it = c; it < 256; it += G) p0_ssm_item(P, zoff, it, lds); }
    {
        LAS float* scr = (LAS float*)(lds + wave * 16384);
        const int gw = c * 8 + wave, NGW = G * 8;
        constexpr int I_IN = 16 * 176, I_OUT = 44 * 32, I_MI = 16 * 48, I_MO = 16 * 32, PER_LAYER = 2 * I_IN + 2 * I_OUT + I_MI + I_MO;
        for (int rp = 0; rp <= ((PROBE_P0 >> 1) & 1); ++rp)
        for (int it = gw; it < 2 * PER_LAYER; it += NGW) {
            const int l = it / PER_LAYER; int r = it % PER_LAYER;
            unsigned char* wb = P.ws + OFF_W + (size_t)l * W_LAYER;
            if (r < I_IN) { p0_transpose_item(P.in[2 + zoff] + (size_t)l * 1024 * 5632, 1024, 5632, (bf16_t*)(wb + W_IN1), P.in[1 + zoff] + l * 1024, true, scr, r, lane); continue; } r -= I_IN;
            if (r < I_OUT) { p0_transpose_item(P.in[3 + zoff] + (size_t)l * 2816 * 1024, 2816, 1024, (bf16_t*)(wb + W_OUT1), nullptr, false, scr, r, lane); continue; } r -= I_OUT;
            if (r < I_MI) { p0_transpose_item(P.in[5 + zoff] + (size_t)l * 1024 * 1536, 1024, 1536, (bf16_t*)(wb + W_MI), P.in[4 + zoff] + l * 1024, false, scr, r, lane); continue; } r -= I_MI;
            if (r < I_MO) { p0_transpose_item(P.in[21 + zoff] + (size_t)l * 1024 * 1024, 1024, 1024, (bf16_t*)(wb + W_MO), nullptr, false, scr, r, lane); continue; } r -= I_MO;
            if (r < I_IN) { p0_transpose_item(P.in[23 + zoff] + (size_t)l * 1024 * 5632, 1024, 5632, (bf16_t*)(wb + W_IN2), P.in[22 + zoff] + l * 1024, true, scr, r, lane); continue; } r -= I_IN;
            p0_transpose_item(P.in[24 + zoff] + (size_t)l * 2816 * 1024, 2816, 1024, (bf16_t*)(wb + W_OUT2), nullptr, false, scr, r, lane);
        }
    }
    {
        bf16_t* xb = (bf16_t*)(P.ws + OFF_XB); float* ssq = (float*)(P.ws + OFF_SSQ);
        for (int rp = 0; rp <= ((PROBE_P0 >> 2) & 1); ++rp)
        for (int row = c * 8 + wave; row < MTOK; row += G * 32) {
            f32x4 v[4][4];
#pragma unroll
            for (int r = 0; r < 4; ++r) {
                const f32x4* xr = (const f32x4*)(P.in[0 + zoff] + (size_t)(row + r * G * 8) * DM) + lane;
#pragma unroll
                for (int j = 0; j < 4; ++j) v[r][j] = xr[64 * j];
            }
#pragma unroll
            for (int r = 0; r < 4; ++r) {
                const int rw = row + r * G * 8;
                float s = 0.f;
#pragma unroll
                for (int j = 0; j < 4; ++j) s += (v[r][j].x * v[r][j].x + v[r][j].y * v[r][j].y) + (v[r][j].z * v[r][j].z + v[r][j].w * v[r][j].w);
                s = wave_sum(s, lane);
                u32x2* o8 = (u32x2*)(xb + (size_t)rw * DM) + lane;
#pragma unroll
                for (int j = 0; j < 4; ++j) { u32x2 w; w.x = cvt_pk_bf16(v[r][j].x, v[r][j].y); w.y = cvt_pk_bf16(v[r][j].z, v[r][j].w); o8[64 * j] = w; }
                if (lane < 4) ssq[(size_t)rw * 4 + lane] = (lane == 0) ? s : 0.f;
            }
        }
    }
    {
        for (int idx = (c * 512 + tid); idx < 2 * 4 * 256 * 32; idx += G * 512) {
            const int s8 = idx & 31, t2 = (idx >> 5) & 255, h = (idx >> 13) & 3, l = idx >> 15;
            const int t = t2 & 127, s0 = (s8 * 8) & 127;
            const bool same = ((s8 * 8) >> 7) == (t2 >> 7);
            const float* src = P.in[17 + zoff] + ((size_t)(l * 4 + h) * 128 + t) * 128 + s0;
            float o[8];
#pragma unroll
            for (int j = 0; j < 8; ++j) o[j] = (same && (s0 + j) <= t) ? src[j] : 0.f;
            u32x4 w; w.x = cvt_pk_bf16(o[0], o[1]); w.y = cvt_pk_bf16(o[2], o[3]); w.z = cvt_pk_bf16(o[4], o[5]); w.w = cvt_pk_bf16(o[6], o[7]);
            *(u32x4*)((bf16_t*)(P.ws + OFF_WEXP + (size_t)l * SZ_WEXP) + ((size_t)(h * 256 + t2) * 256 + s8 * 8)) = w;
        }
    }
    if (!ssm_first) { __syncthreads(); for (int it = c; it < 256; it += G) p0_ssm_item(P, zoff, it, lds); }
}

__device__ __forceinline__ void vfix_phase(unsigned char* ws, LAS unsigned char* lds, int c, int G) {
    int tid = threadIdx.x; asm volatile("" : "+v"(tid));
    const bf16_t* gv = (const bf16_t*)(ws + OFF_GV); bf16_t* VT = (bf16_t*)(ws + OFF_VT);
    LAS bf16_t* T = (LAS bf16_t*)lds;
    const bool bal = (G == 256);
    const int it_lo = bal ? (c < 128 ? 3 * c : 384 + 5 * (c - 128)) : c, it_n = bal ? (c < 128 ? 3 : 5) : (1024 - c + G - 1) / G, it_st = bal ? 1 : G;
    for (int ii = 0; ii < it_n; ++ii) {
        const int it = it_lo + ii * it_st;
        const int h = it & 3, bn = it >> 2;
        for (int pass = 0; pass < 8; ++pass) {
            const int row = pass * 32 + (tid >> 4), ch = tid & 15;
            const u32x4 w = *(const u32x4*)(gv + (size_t)(bn * 256 + row) * 512 + h * 128 + ch * 8);
            float v[8] = {bf_lo(w.x), bf_hi(w.x), bf_lo(w.y), bf_hi(w.y), bf_lo(w.z), bf_hi(w.z), bf_lo(w.w), bf_hi(w.w)};
            float s = 0.f;
#pragma unroll
            for (int j = 0; j < 8; ++j) s += v[j] * v[j];
            { const int ln = tid & 63; s += shx(s, 1, ln); s += shx(s, 2, ln); s += shx(s, 4, ln); s += shx(s, 8, ln); }
            const float rs = __builtin_amdgcn_rsqf(s * (1.0f / 128.0f) + EPS);
#pragma unroll
            for (int j = 0; j < 8; j += 2) { const unsigned pk = cvt_pk_bf16(v[j] * rs, v[j + 1] * rs); T[(ch * 8 + j) * 264 + row] = (bf16_t)(pk & 0xffffu); T[(ch * 8 + j + 1) * 264 + row] = (bf16_t)(pk >> 16); }
        }
        __syncthreads();
        bf16_t* dst = VT + (size_t)(h * 256 + bn) * 128 * 256;
        for (int idx = tid; idx < 128 * 32; idx += 512) {
            const int d = idx >> 5, sg = idx & 31;
            *(u32x4*)(dst + (size_t)d * 256 + sg * 8) = *(const LAS u32x4*)(T + d * 264 + sg * 8);
        }
        __syncthreads();
    }
}

typedef float f32x16 __attribute__((ext_vector_type(16)));
__device__ __forceinline__ void post_phase(const Params& P, int zoff, unsigned char* ws, int l, LAS unsigned char* lds, int c, int G) {
    int tid = threadIdx.x; asm volatile("" : "+v"(tid));
    const int lane = tid & 63, wave = tid >> 6, tl = lane & 31, kh = lane >> 5;
    const bf16_t* yraw = (const bf16_t*)(ws + OFF_YRAW); const bf16_t* ygm = (const bf16_t*)(ws + OFF_YGM); bf16_t* Y = (bf16_t*)(ws + OFF_Y);
    const float* gw = P.in[14 + zoff] + (size_t)l * 32 * 512; const float* gb = P.in[15 + zoff] + (size_t)l * 1024;
    const float* gs = P.in[19 + zoff] + l * 512; const float* gg = P.in[20 + zoff] + l * 512;
    LAS u32x4* Wl = (LAS u32x4*)lds;
    LAS float* Bl = (LAS float*)(lds + 32768);
    LAS float* Gl = Bl + 1024;
    for (int idx = tid; idx < 32 * 64; idx += 512) {
        const int g = idx >> 6, ln = idx & 63;
        const float* wp = gw + g * 512 + (8 * (ln >> 5)) * 32 + (ln & 31);
        u32x4 ap; ap.x = cvt_pk_bf16(wp[0], wp[32]); ap.y = cvt_pk_bf16(wp[64], wp[96]); ap.z = cvt_pk_bf16(wp[128], wp[160]); ap.w = cvt_pk_bf16(wp[192], wp[224]);
        Wl[idx] = ap;
    }
    for (int i = tid; i < 1024; i += 512) Bl[i] = gb[i];
    Gl[tid] = gs[tid];
    __syncthreads();
    for (int item = c; item < MTOK / 256; item += G) {
        const int tok = item * 256 + wave * 32 + tl;
        const bf16_t* yr = yraw + (size_t)tok * 512 + kh * 8;
        bf16_t* yo = Y + (size_t)tok * 1024 + 4 * kh;
        const bool gm_first = (((c >> 3) & 1) != 0);
        if (gm_first) {
            const f32x4 ga = *(const f32x4*)(gg + lane * 8), gbv = *(const f32x4*)(gg + lane * 8 + 4);
    #pragma unroll 1
            for (int r0 = 0; r0 < 32; r0 += 8) {
                u32x4 wv[8];
    #pragma unroll
                for (int j = 0; j < 8; ++j) wv[j] = *(const u32x4*)(ygm + (size_t)(item * 256 + wave * 32 + r0 + j) * 512 + lane * 8);
    #pragma unroll
                for (int j = 0; j < 8; ++j) {
                    const u32x4 w = wv[j];
                    float v[8] = {bf_lo(w.x), bf_hi(w.x), bf_lo(w.y), bf_hi(w.y), bf_lo(w.z), bf_hi(w.z), bf_lo(w.w), bf_hi(w.w)};
                    float s = 0.f;
    #pragma unroll
                    for (int k = 0; k < 8; ++k) s += v[k] * v[k];
                    s = wave_sum(s, lane);
                    const float r2 = __builtin_amdgcn_rsqf(s * (1.0f / 512.0f) + EPS);
                    u32x4 o; o.x = cvt_pk_bf16(v[0] * r2 * ga.x, v[1] * r2 * ga.y); o.y = cvt_pk_bf16(v[2] * r2 * ga.z, v[3] * r2 * ga.w);
                    o.z = cvt_pk_bf16(v[4] * r2 * gbv.x, v[5] * r2 * gbv.y); o.w = cvt_pk_bf16(v[6] * r2 * gbv.z, v[7] * r2 * gbv.w);
                    *(u32x4*)(Y + (size_t)(item * 256 + wave * 32 + r0 + j) * 1024 + 512 + lane * 8) = o;
                }
            }
        }
        float ss = 0.f, rs = 0.f;
#pragma unroll 1
        for (int pass = 0; pass < 2; ++pass) {
#pragma unroll 1
            for (int g8 = 0; g8 < 32; g8 += 8) {
                u32x4 yv[8];
#pragma unroll
                for (int j = 0; j < 8; ++j) yv[j] = *(const u32x4*)(yr + (g8 + j) * 16);
#pragma unroll
                for (int j = 0; j < 8; ++j) {
                    const int g = g8 + j;
                    u32x4 ap = Wl[g * 64 + lane];
                    u32x4 bp;
                    bp.x = cvt_pk_bf16(gelu_tanh(bf_lo(yv[j].x)), gelu_tanh(bf_hi(yv[j].x))); bp.y = cvt_pk_bf16(gelu_tanh(bf_lo(yv[j].y)), gelu_tanh(bf_hi(yv[j].y)));
                    bp.z = cvt_pk_bf16(gelu_tanh(bf_lo(yv[j].z)), gelu_tanh(bf_hi(yv[j].z))); bp.w = cvt_pk_bf16(gelu_tanh(bf_lo(yv[j].w)), gelu_tanh(bf_hi(yv[j].w)));
                    f32x16 acc;
#pragma unroll
                    for (int q = 0; q < 4; ++q) { const f32x4 bv = *(const LAS f32x4*)(Bl + g * 32 + 8 * q + 4 * kh); acc[4 * q] = bv.x; acc[4 * q + 1] = bv.y; acc[4 * q + 2] = bv.z; acc[4 * q + 3] = bv.w; }
                    asm volatile("s_nop 4" : "+v"(ap), "+v"(bp));
                    acc = __builtin_amdgcn_mfma_f32_32x32x16_bf16(__builtin_bit_cast(bf16x8, ap), __builtin_bit_cast(bf16x8, bp), acc, 0, 0, 0);
#pragma unroll
                    for (int q = 0; q < 2; ++q) {
                        float o[4];
#pragma unroll
                        for (int r = 0; r < 4; ++r) o[r] = acc[4 * q + r] * fast_sigmoid(acc[4 * (q + 2) + r]);
                        u32x2 w; w.x = cvt_pk_bf16(o[0], o[1]); w.y = cvt_pk_bf16(o[2], o[3]);
                        if (pass == 0) {
                            ss += (bf_lo(w.x) * bf_lo(w.x) + bf_hi(w.x) * bf_hi(w.x)) + (bf_lo(w.y) * bf_lo(w.y) + bf_hi(w.y) * bf_hi(w.y));
                        } else {
                            const int off = g * 16 + 8 * q;
                            const f32x4 gn = *(const LAS f32x4*)(Gl + off + 4 * kh);
                            u32x2 ov; ov.x = cvt_pk_bf16(bf_lo(w.x) * rs * gn.x, bf_hi(w.x) * rs * gn.y); ov.y = cvt_pk_bf16(bf_lo(w.y) * rs * gn.z, bf_hi(w.y) * rs * gn.w);
                            *(u32x2*)(yo + off) = ov;
                        }
                    }
                }
            }
            if (pass == 0) { ss += shx(ss, 32, lane); rs = __builtin_amdgcn_rsqf(ss * (1.0f / 512.0f) + EPS); }
        }
        if (!gm_first) {
            const f32x4 ga = *(const f32x4*)(gg + lane * 8), gbv = *(const f32x4*)(gg + lane * 8 + 4);
    #pragma unroll 1
            for (int r0 = 0; r0 < 32; r0 += 8) {
                u32x4 wv[8];
    #pragma unroll
                for (int j = 0; j < 8; ++j) wv[j] = *(const u32x4*)(ygm + (size_t)(item * 256 + wave * 32 + r0 + j) * 512 + lane * 8);
    #pragma unroll
                for (int j = 0; j < 8; ++j) {
                    const u32x4 w = wv[j];
                    float v[8] = {bf_lo(w.x), bf_hi(w.x), bf_lo(w.y), bf_hi(w.y), bf_lo(w.z), bf_hi(w.z), bf_lo(w.w), bf_hi(w.w)};
                    float s = 0.f;
    #pragma unroll
                    for (int k = 0; k < 8; ++k) s += v[k] * v[k];
                    s = wave_sum(s, lane);
                    const float r2 = __builtin_amdgcn_rsqf(s * (1.0f / 512.0f) + EPS);
                    u32x4 o; o.x = cvt_pk_bf16(v[0] * r2 * ga.x, v[1] * r2 * ga.y); o.y = cvt_pk_bf16(v[2] * r2 * ga.z, v[3] * r2 * ga.w);
                    o.z = cvt_pk_bf16(v[4] * r2 * gbv.x, v[5] * r2 * gbv.y); o.w = cvt_pk_bf16(v[6] * r2 * gbv.z, v[7] * r2 * gbv.w);
                    *(u32x4*)(Y + (size_t)(item * 256 + wave * 32 + r0 + j) * 1024 + 512 + lane * 8) = o;
                }
            }
        }
    }
    __syncthreads();
}

__device__ __forceinline__ void final_phase(const Params& P, int zoff, unsigned char* ws, int c, int G) {
    int tid = threadIdx.x; asm volatile("" : "+v"(tid));
    const int lane = tid & 63, wave = tid >> 6;
    const bf16_t* xb = (const bf16_t*)(ws + OFF_XB);
    const float* gn = P.in[25 + zoff];
    const f32x4 g0 = *(const f32x4*)(gn + lane * 8), g1 = *(const f32x4*)(gn + lane * 8 + 4), g2 = *(const f32x4*)(gn + 512 + lane * 8), g3 = *(const f32x4*)(gn + 512 + lane * 8 + 4);
    for (int row = c * 8 + wave; row < MTOK; row += G * 32) {
        u32x4 av[4], bv[4];
#pragma unroll
        for (int r = 0; r < 4; ++r) { const bf16_t* xp = xb + (size_t)(row + r * G * 8) * DM + lane * 8; av[r] = *(const u32x4*)xp; bv[r] = *(const u32x4*)(xp + 512); }
#pragma unroll
        for (int r = 0; r < 4; ++r) {
            const u32x4 a = av[r], b = bv[r];
            const f32x4 v0 = {bf_lo(a.x), bf_hi(a.x), bf_lo(a.y), bf_hi(a.y)}, v1 = {bf_lo(a.z), bf_hi(a.z), bf_lo(a.w), bf_hi(a.w)};
            const f32x4 v2 = {bf_lo(b.x), bf_hi(b.x), bf_lo(b.y), bf_hi(b.y)}, v3 = {bf_lo(b.z), bf_hi(b.z), bf_lo(b.w), bf_hi(b.w)};
            float s = (v0.x * v0.x + v0.y * v0.y) + (v0.z * v0.z + v0.w * v0.w) + (v1.x * v1.x + v1.y * v1.y) + (v1.z * v1.z + v1.w * v1.w)
                    + (v2.x * v2.x + v2.y * v2.y) + (v2.z * v2.z + v2.w * v2.w) + (v3.x * v3.x + v3.y * v3.y) + (v3.z * v3.z + v3.w * v3.w);
            s = wave_sum(s, lane);
            const float rs = __builtin_amdgcn_rsqf(s * (1.0f / 1024.0f) + EPS);
            float* o = P.out + (size_t)(row + r * G * 8) * DM + lane * 8;
            *(f32x4*)o = v0 * rs * g0; *(f32x4*)(o + 4) = v1 * rs * g1; *(f32x4*)(o + 512) = v2 * rs * g2; *(f32x4*)(o + 516) = v3 * rs * g3;
        }
    }
}

#ifndef MK_MSPLIT
#define MK_MSPLIT 1
#endif
constexpr int NSTEP = MK_MSPLIT ? 13 : 9;
constexpr int N_PHASES = 1 + 2 * NSTEP + 1;

__global__ void __launch_bounds__(512, 2) mk_fwd(Params P) {
    extern __shared__ __attribute__((aligned(16))) unsigned char shm[];
    LAS unsigned char* lds = (LAS unsigned char*)shm;
    if (threadIdx.x < 4) ((LAS unsigned*)(lds + LDS_BARW))[threadIdx.x] = 0u;
    if (threadIdx.x == 0) {
        unsigned* bar0 = (unsigned*)(P.ws + OFF_BAR); const unsigned x = xb_xcc_id();
        (void)xb_add(&bar0[XB_XCNT(x)], 1u);
#if MK_VCU
        const unsigned rk = xb_add(&bar0[XB_VC(x & 7u)], 1u);
        ((LAS unsigned*)(lds + LDS_BARW))[2] = rk * 8u + (x & 7u);
#endif
    }
    __syncthreads();
    for (int ph = P.ph_lo; ph < P.ph_hi; ++ph) {
        int kind = 7;
        int s = 0, l = 0, half = 0, nhalf = 1;
        if (ph == 0) kind = 0; else if (ph < N_PHASES - 1) {
            l = (ph - 1) / NSTEP; const int s_ = (ph - 1) % NSTEP;
            if (MK_MSPLIT) {
                nhalf = 2;
                if (s_ < 4) { s = s_ & 1; half = s_ >> 1; } else if (s_ < 9) { s = s_ - 2; } else { s = 7 + ((s_ - 9) & 1); half = (s_ - 9) >> 1; }
            } else s = s_;
            kind = (s == 0 || s == 7) ? 1 : (s == 2) ? 2 : (s == 3) ? 3 : (s == 4) ? 4 : (s == 5) ? 5 : 6; }
        const int reps = 1 + ((PROBE_DUP >> kind) & 1);
        for (int rep = 0; rep < reps; ++rep) {
        unsigned char* ws = P.ws; int zoff = 0, c = blockIdx.x, G = gridDim.x;
#if MK_VCU
        if (ph > 0 && G == 256) {
            unsigned* bar0 = (unsigned*)(ws + OFF_BAR); bool ok = true;
#pragma unroll
            for (int j = 0; j < 8; ++j) ok = ok && (xb_ld(&bar0[XB_VC(j)]) == 32u);
            if (ok) c = (int)__builtin_amdgcn_readfirstlane(((volatile LAS unsigned*)(lds + LDS_BARW))[2]);
        }
#endif
        asm volatile("" : "+s"(ws), "+s"(zoff), "+s"(c), "+s"(G));
        bf16_t* xb = (bf16_t*)(ws + OFF_XB); bf16_t* hid = (bf16_t*)(ws + OFF_HID); float* ssq = (float*)(ws + OFF_SSQ);
        const int kro = MK_KROT ? ((((c >> 3) >> 3) * 4 + ((c >> 3) & 7) * 2)) : 0;
        bf16_t* Assm = (bf16_t*)(ws + OFF_ASSM); bf16_t* gu = (bf16_t*)(ws + OFF_GU); bf16_t* gv = (bf16_t*)(ws + OFF_GV);
        bf16_t* VT = (bf16_t*)(ws + OFF_VT); bf16_t* yraw = (bf16_t*)(ws + OFF_YRAW); bf16_t* Y = (bf16_t*)(ws + OFF_Y); bf16_t* ygm = (bf16_t*)(ws + OFF_YGM);
        if (ph == 0) {
#if (MK_MASK & 1)
            phase0(P, zoff, lds, c, G);
#endif
        } else if (ph == N_PHASES - 1) {
#if (MK_MASK & 2)
            final_phase(P, zoff, ws, c, G);
#endif
        } else {
            const unsigned char* wb = ws + OFF_W + (size_t)l * W_LAYER;
            if (s == 0 || s == 7) {
#if (MK_MASK & 4)
                pg8::Gemm g{xb, (const bf16_t*)(wb + (s == 0 ? W_IN1 : W_IN2)), DM, DM, DM, kro % 16};
                const int isE1split = MK_MSPLIT ? 1 : 0; const size_t r0 = (size_t)half * (MTOK / 2) * isE1split; const int mrows = isE1split ? MTOK / 2 : MTOK;
                g.A = xb + r0 * DM;
                pg8::StaticOrder S; S.init(mrows, 2 * DFF, G, c);
                EpiSwiglu E{hid + r0 * DFF, ssq + r0 * 4, lds};
                pg8::gemm_phase(lds, g, S, E);
#if PROBE_E1VAR
                { __syncthreads(); pg8::OrderSame S2{G, c, 1, S}; EpiSwiglu E2{(bf16_t*)(ws + WS_END), ssq, lds}; pg8::Gemm g2 = g; int kk2 = (PROBE_E1VAR == 3) ? 512 : 1024; asm volatile("" : "+s"(kk2)); g2.K = kk2; pg8::gemm_phase(lds, g2, S2, E2); }
#endif
#endif
            } else if (s == 1 || s == 6 || s == 8) {
#if (MK_MASK & 8)
                pg8::Gemm g;
                if (s == 6) g = pg8::Gemm{Y, (const bf16_t*)(wb + W_MO), DM, DM, DM, kro % 16};
                else g = pg8::Gemm{hid, (const bf16_t*)(wb + (s == 1 ? W_OUT1 : W_OUT2)), DFF, DFF, DFF, kro % 44};
                const bool spl = MK_MSPLIT && s != 6; const size_t r0 = spl ? (size_t)half * (MTOK / 2) : 0; const int mrows = spl ? MTOK / 2 : MTOK;
                g.A = g.A + r0 * g.lda;
                pg8::StaticOrder S; S.init(mrows, DM, G, c, (spl && MK_E2REV) ? 15 : 0);
                EpiResid E{xb + r0 * DM, ssq + r0 * 4, rep ? 0.0f : ((s == 6) ? 1.0f : 0.5f), (LAS float*)(lds + LDS_SPARE)};
                pg8::gemm_phase(lds, g, S, E);
#endif
            } else if (s == 2) {
#if (MK_MASK & 16)
                pg8::Gemm g{xb, (const bf16_t*)(wb + W_MI), DM, DM, DM, kro % 16};
                pg8::StaticOrder S; S.init(MTOK, NIN, G, c);
                EpiMixIn E{Assm, gu, gv, ssq, lds};
                pg8::gemm_phase(lds, g, S, E);
#endif
            } else if (s == 3) {
#if (MK_MASK & 32)
                vfix_phase(ws, lds, c, G);
                pg8::Gemm g{Assm + 128, (const bf16_t*)(ws + OFF_BST + (size_t)l * SZ_BST), KSSM, 1024, 1024, 0};
                pg8::OrderState S{G, c};
                EpiState E{Assm, P.in[6 + zoff] + l * 2048, P.in[7 + zoff] + l * 2048, P.in[8 + zoff] + l * 32};
                pg8::gemm_phase<EpiState, pg8::OrderState, false, true>(lds, g, S, E);
                __syncthreads();
#endif
            } else if (s == 4) {
#if (MK_MASK & 64)
                {
                    pg8::Gemm g{Assm, (const bf16_t*)(ws + OFF_BSSM + (size_t)l * SZ_BSSM), KSSM, KSSM, KSSM, 0};
                    pg8::OrderSsm S{G, c};
                    EpiSsmY E{yraw};
                    pg8::gemm_phase(lds, g, S, E);
                }
#endif
#if (MK_MASK & 128)
                {
                    int kk = 256; asm volatile("" : "+s"(kk));
                    pg8::Gemm g{(const bf16_t*)(ws + OFF_WEXP + (size_t)l * SZ_WEXP), VT, 256, 256, kk, 0};
                    pg8::OrderGm S{G, c};
                    EpiGm E{gu, ygm, P.in[16 + zoff] + l * 512, P.in[18 + zoff] + l * 512};
                    pg8::gemm_phase(lds, g, S, E);
                }
#endif
            } else {
#if (MK_MASK & 256)
                post_phase(P, zoff, ws, l, lds, c, G);
#endif
            }
        }
        }
#if MK_COOP
        if (ph + 1 < P.ph_hi) {
            if (P.ph_hi > 4096) cg::this_grid().sync(); else xcd_barrier((unsigned*)(P.ws + OFF_BAR), (volatile LAS unsigned*)(lds + LDS_BARW)); }
#endif
    }
#if MK_COOP
    for (int i = 0; i < PROBE_SYNC; ++i) xcd_barrier((unsigned*)(P.ws + OFF_BAR), (volatile LAS unsigned*)(lds + LDS_BARW));
#endif
}

extern "C" void kernel_launch(void* const* d_in, const int* in_sizes, int n_in, void* d_out, int out_size, void* d_ws, size_t ws_size, hipStream_t stream) {
    static int grid = 0;
    if (grid == 0) {
        if (n_in != 26 || out_size != MTOK * DM || ws_size < WS_END) { fprintf(stderr, "kernel_launch: unexpected shapes (n_in %d, out %d, ws %zu, need %zu)\n", n_in, out_size, ws_size, (size_t)WS_END); grid = -1; return; }
        int dev = 0, cus = 0, per_cu = 0;
        hipGetDevice(&dev);
        hipDeviceGetAttribute(&cus, hipDeviceAttributeMultiprocessorCount, dev);
        if (hipFuncSetAttribute((const void*)mk_fwd, hipFuncAttributeMaxDynamicSharedMemorySize, LDS_BYTES) != hipSuccess) { fprintf(stderr, "kernel_launch: hipFuncSetAttribute failed\n"); grid = -1; return; }
        hipOccupancyMaxActiveBlocksPerMultiprocessor(&per_cu, (const void*)mk_fwd, 512, LDS_BYTES);
        if (per_cu < 1) { fprintf(stderr, "kernel_launch: occupancy query says %d\n", per_cu); per_cu = 1; }
        (void)hipGetLastError();
        grid = cus;
    }
    if (grid < 0) return;
    if (hipMemsetAsync((char*)d_ws + OFF_BAR, 0, SZ_BAR, stream) != hipSuccess) { fprintf(stderr, "kernel_launch: memset failed\n"); return; }
    Params p{};
    for (int i = 0; i < 26; ++i) p.in[i] = (const float*)d_in[i];
    p.out = (float*)d_out; p.ws = (unsigned char*)d_ws;
#if MK_COOP
    p.ph_lo = 0; p.ph_hi = N_PHASES;
    void* args[] = {&p};
    hipError_t e = hipLaunchCooperativeKernel((const void*)mk_fwd, dim3(grid), dim3(512), args, LDS_BYTES, stream);
    if (e != hipSuccess) fprintf(stderr, "cooperative launch failed: %s (grid %d)\n", hipGetErrorString(e), grid);
#else
    for (int ph = 0; ph < N_PHASES; ++ph) {
        p.ph_lo = ph; p.ph_hi = ph + 1;
        hipLaunchKernelGGL(mk_fwd, dim3(grid), dim3(512), LDS_BYTES, stream, p);
    }
#endif
}
```

```cpp
#include <hip/hip_runtime.h>
#include <hip/hip_cooperative_groups.h>
#include <cstdio>
#include <cstdint>
namespace cg = cooperative_groups;

#ifndef MK_COOP
#define MK_COOP 1
#endif
#ifndef MK_MASK
#define MK_MASK 0xffff
#endif
#ifndef PROBE_DUP
#define PROBE_DUP 0
#endif
#ifndef PROBE_EPI
#define PROBE_EPI 0
#endif
#ifndef PROBE_E1VAR
#define PROBE_E1VAR 0
#endif
#ifndef MK_KROT
#define MK_KROT 0
#endif
#ifndef PROBE_P0
#define PROBE_P0 0
#endif
#ifndef MK_VCU
#define MK_VCU 0
#endif
#ifndef MK_E2REV
#define MK_E2REV 0
#endif
#ifndef PROBE_SYNC
#define PROBE_SYNC 0
#endif

#define LAS __attribute__((address_space(3)))
typedef unsigned short bf16_t;
typedef short bf16x8 __attribute__((ext_vector_type(8)));
typedef float f32x4 __attribute__((ext_vector_type(4)));
typedef float f32x2 __attribute__((ext_vector_type(2)));
typedef unsigned u32x4 __attribute__((ext_vector_type(4)));
typedef unsigned u32x2 __attribute__((ext_vector_type(2)));

constexpr int DM = 1024, NBATCH = 32, SEQ = 2048, MTOK = NBATCH * SEQ, DFF = 2816, NIN = 1536;
constexpr float EPS = 1e-6f;
constexpr int KSSM = 1152;

constexpr size_t SZ_XB = (size_t)MTOK * DM * 2;
constexpr size_t SZ_HID = (size_t)MTOK * DFF * 2;
constexpr size_t SZ_ASSM = (size_t)32768 * KSSM * 2;
constexpr size_t SZ_T512 = (size_t)MTOK * 512 * 2;
constexpr size_t OFF_XB = 0;
constexpr size_t OFF_HID = OFF_XB + SZ_XB;
constexpr size_t OFF_ASSM = OFF_HID;
constexpr size_t OFF_GU = OFF_ASSM + SZ_ASSM;
constexpr size_t OFF_GV = OFF_GU + SZ_T512;
constexpr size_t OFF_VT = OFF_GV + SZ_T512;
constexpr size_t OFF_YRAW = OFF_VT + SZ_T512;
constexpr size_t OFF_Y = OFF_GV;
static_assert(OFF_YRAW + SZ_T512 <= OFF_HID + SZ_HID, "mix buffers must fit in the hid region");
constexpr size_t OFF_YGM = OFF_HID + SZ_HID;
constexpr size_t OFF_W = OFF_YGM + SZ_T512;
constexpr size_t W_IN1 = 0, W_OUT1 = W_IN1 + (size_t)5632 * 1024 * 2, W_MI = W_OUT1 + (size_t)1024 * 2816 * 2,
                 W_MO = W_MI + (size_t)1536 * 1024 * 2, W_IN2 = W_MO + (size_t)1024 * 1024 * 2, W_OUT2 = W_IN2 + (size_t)5632 * 1024 * 2,
                 W_LAYER = W_OUT2 + (size_t)1024 * 2816 * 2;
constexpr size_t OFF_BSSM = OFF_W + 2 * W_LAYER;
constexpr size_t SZ_BSSM = (size_t)32 * 1024 * KSSM * 2;
constexpr size_t OFF_BST = OFF_BSSM + 2 * SZ_BSSM;
constexpr size_t SZ_BST = (size_t)32 * 256 * 1024 * 2;
constexpr size_t OFF_WEXP = OFF_BST + 2 * SZ_BST;
constexpr size_t SZ_WEXP = (size_t)4 * 256 * 256 * 2;
constexpr size_t OFF_SSQ = OFF_WEXP + 2 * SZ_WEXP;
constexpr size_t SZ_SSQ = (size_t)MTOK * 4 * 4;
constexpr size_t OFF_BAR = OFF_SSQ + SZ_SSQ;
constexpr size_t SZ_BAR = 16384;
constexpr size_t WS_END = OFF_BAR + SZ_BAR;

constexpr int LDS_SPARE = 131072;
constexpr int LDS_BARW = 131072 + 8192;
constexpr int LDS_BYTES = 131072 + 8192 + 64;

struct Params {
    const float* in[26];
    float* out;
    unsigned char* ws;
    int ph_lo, ph_hi;
};

__device__ __forceinline__ unsigned cvt_pk_bf16(float lo, float hi) { unsigned r; asm volatile("v_cvt_pk_bf16_f32 %0, %1, %2" : "=v"(r) : "v"(lo), "v"(hi)); return r; }
__device__ __forceinline__ float bf_lo(unsigned w) { return __uint_as_float(w << 16); }
__device__ __forceinline__ float bf_hi(unsigned w) { return __uint_as_float(w & 0xffff0000u); }
__device__ __forceinline__ float fast_sigmoid(float z) { return __builtin_amdgcn_rcpf(1.0f + __builtin_amdgcn_exp2f(-1.44269504f * z)); }
__device__ __forceinline__ float gelu_tanh(float x) {
    const float z = 1.5957691216f * (x + 0.044715f * x * x * x);
    return x * fast_sigmoid(z);
}
__device__ __forceinline__ float silu(float x) { return x * fast_sigmoid(x); }
__device__ __forceinline__ float shx(float v, int mask, int lane) { return __int_as_float(__builtin_amdgcn_ds_bpermute((lane ^ mask) << 2, __float_as_int(v))); }
__device__ __forceinline__ float wave_sum(float v, int lane) {
#pragma unroll
    for (int o = 1; o < 64; o <<= 1) v += shx(v, o, lane);
    return v;
}
__device__ __forceinline__ float rstd_from_ssq(const float* ssq, int row) {
    const f32x4 a = *(const f32x4*)(ssq + (size_t)row * 4);
    return __builtin_amdgcn_rsqf(((a.x + a.y) + (a.z + a.w)) * (1.0f / 1024.0f) + EPS);
}
__device__ __forceinline__ f32x2 lam_pow(float are, float aim, float dt, int k) {
    const float mag = __expf((float)k * dt * are);
    double rev = (double)k * (double)dt * (double)aim * 0.15915494309189535;
    rev -= __builtin_rint(rev);
    const float r = (float)rev;
    return (f32x2){mag * __builtin_amdgcn_cosf(r), mag * __builtin_amdgcn_sinf(r)};
}


#define XB_TMO      128
#define XB_XCNT(j)  (256  + 64 * (j))
#define XB_XSUB(j)  (1280 + 64 * (j))
#define XB_XGEN(j)  (2304 + 64 * (j))
#define XB_TOP      3328
#define XB_TOPGEN   3392
#define XCD_BAR_WORDS 3456
#define XB_VC(j)    (3584 + 64 * (j))
#define XB_SPIN_CAP (1u << 18)
__device__ __forceinline__ unsigned xb_ld(unsigned* p)              { return __hip_atomic_load(p, __ATOMIC_RELAXED, __HIP_MEMORY_SCOPE_AGENT); }
__device__ __forceinline__ unsigned xb_add(unsigned* p, unsigned v) { return __hip_atomic_fetch_add(p, v, __ATOMIC_RELAXED, __HIP_MEMORY_SCOPE_AGENT); }
__device__ __forceinline__ unsigned xb_xcc_id() { return (unsigned)__builtin_amdgcn_s_getreg((3 << 11) | 20) & 0xFu; }
#define XB_SPIN(cond, bar) do { unsigned _sp = 0; while (cond) { __builtin_amdgcn_s_sleep(1); \
    if ((++_sp & 255u) == 0u) { if (xb_ld(&(bar)[XB_TMO])) break; if (_sp > XB_SPIN_CAP) { atomicAdd(&(bar)[XB_TMO], 1u); break; } } } } while (0)
__device__ __forceinline__ void xcd_barrier_complete(unsigned* bar, unsigned x, unsigned& nloc, unsigned& nx) {
    const unsigned G = gridDim.x * gridDim.y * gridDim.z;
    unsigned sum, cnt, mine, sp = 0u;
    for (;;) {
        sum = 0u; cnt = 0u; mine = 0u;
#pragma unroll
        for (unsigned j = 0; j < 16; ++j) { const unsigned c = xb_ld(&bar[XB_XCNT(j)]); sum += c; cnt += (c > 0u) ? 1u : 0u; mine = (j == x) ? c : mine; }
        if (sum == G) break;
        __builtin_amdgcn_s_sleep(1);
        if ((++sp & 255u) == 0u) { if (xb_ld(&bar[XB_TMO])) break; if (sp > XB_SPIN_CAP) { atomicAdd(&bar[XB_TMO], 1u); break; } }
    }
    nloc = mine > 0u ? mine : 1u; nx = cnt > 0u ? cnt : 1u;
}
__device__ __forceinline__ void xcd_barrier(unsigned* bar, volatile LAS unsigned* st) {
    asm volatile("" : "+s"(bar));
    asm volatile("s_waitcnt vmcnt(0)" ::: "memory");
    __syncthreads();
    int t0 = threadIdx.x; asm volatile("" : "+v"(t0));
    if (t0 == 0) {
        __builtin_amdgcn_s_waitcnt(0);
        const unsigned x = xb_xcc_id();
        unsigned nloc = st[0], nx = st[1];
        if (nloc == 0u) { xcd_barrier_complete(bar, x, nloc, nx); st[0] = nloc; st[1] = nx; }
        const unsigned old = xb_add(&bar[XB_XSUB(x)], 1u);
        const unsigned gen = old / nloc;
        if (old + 1u == (gen + 1u) * nloc) {
            __builtin_amdgcn_fence(__ATOMIC_RELEASE, "agent");
            asm volatile("s_waitcnt vmcnt(0)" ::: "memory");
            const unsigned og = xb_add(&bar[XB_TOP], 1u);
            const unsigned tg = og / nx;
            if (og + 1u == (tg + 1u) * nx) xb_add(&bar[XB_TOPGEN], 1u);
            else XB_SPIN(xb_ld(&bar[XB_TOPGEN]) == tg, bar);
            __builtin_amdgcn_fence(__ATOMIC_ACQUIRE, "agent");
            xb_add(&bar[XB_XGEN(x)], 1u);
            asm volatile("s_waitcnt vmcnt(0)" ::: "memory");
        } else {
            XB_SPIN(xb_ld(&bar[XB_XGEN(x)]) == gen, bar);
            __builtin_amdgcn_fence(__ATOMIC_ACQUIRE, "agent");
            asm volatile("s_waitcnt vmcnt(0)" ::: "memory");
        }
    }
    __syncthreads();
}

namespace pg8 {
constexpr int BM = 256, BK = 64, HALF = 128, HTB = HALF * BK * 2, STAGE_BYTES = 8 * HTB, NXCD = 8, WGM = 8;
__host__ __device__ __forceinline__ int lds_byte(int r, int c) { const int st = (r >> 4) * 2 + (c >> 5), rr = r & 15, cc = c & 31, ob = rr * 64 + cc * 2; return st * 1024 + (ob ^ (((ob >> 9) & 1) << 5)); }
__host__ __device__ __forceinline__ void stage_rc(int b, int& R, int& C) { const int st = b / 1024, sb = b % 1024, swz = sb ^ (((sb >> 9) & 1) << 5); R = (st >> 1) * 16 + swz / 64; C = (st & 1) * 32 + (swz % 64) / 2; }
__host__ __device__ __forceinline__ int perm32(int rho) { const int n = rho >> 4, i = rho & 15; return 8 * (i >> 2) + 4 * n + (i & 3); }

struct Unit { int pm, pn, par, nt; };
struct Gemm { const bf16_t* A; const bf16_t* Bt; int lda, ldb, K, koff; };

struct StaticOrder {
    static constexpr bool VARK = false;
    int nM, nN, nwg, G, c, rev;
    __device__ void init(int M, int N, int G_, int c_, int rev_ = 0) { nM = M / BM; nN = N / BM; nwg = nM * nN; G = G_; c = c_; rev = rev_; }
    __device__ bool next(int i, Unit& u) const {
        const long L = (long)i * G + c; if (L >= nwg) return false;
        int wgid = (int)L; { const int q = nwg / NXCD, r = nwg % NXCD, xcd = wgid % NXCD, off = wgid / NXCD; wgid = (xcd < r ? xcd * (q + 1) : r * (q + 1) + (xcd - r) * q) + off; }
        const int nig = WGM * nN, gid = wgid / nig, fm = gid * WGM, gsz = (nM - fm) < WGM ? (nM - fm) : WGM;
        u.pm = (fm + ((wgid % nig) % gsz)) ^ rev; u.pn = (wgid % nig) / gsz; return true;
    }
};
struct OrderSsm {
    static constexpr bool VARK = true;
    int G, c;
    __device__ bool next(int i, Unit& u) const {
        const int cc = (i >> 1) * G + c; if (cc >= 256) return false;
        const int su = (G == 256) ? ((cc & 7) * 32 + (cc >> 3)) : cc;
        const int g = su >> 3, pml = (su >> 1) & 3, pair = su & 1, pnl = (i & 1) ? 3 - pair : pair;
        u.pm = 4 * g + pml; u.pn = 4 * g + pnl; u.nt = 2 + 4 * (pnl + 1); return true;
    }
};
struct OrderState {
    static constexpr bool VARK = false;
    int G, c;
    __device__ bool next(int i, Unit& u) const {
        const int L = i * G + c; if (L >= 128) return false;
        const int su = (G == 256) ? ((L & 7) * 16 + (L >> 3)) : L;
        const int g = su >> 2; u.pm = 4 * g + (su & 3); u.pn = g; return true;
    }
};
struct OrderSame { static constexpr bool VARK = false; int G, c, mode; StaticOrder so;
    __device__ bool next(int i, Unit& u) const { if (mode == 2) return so.next(i, u); if (i >= 22) return false; u.pm = 0; u.pn = 0; return true; }
};
struct OrderGm {
    static constexpr bool VARK = false;
    int G, c;
    __device__ bool next(int i, Unit& u) const { const int L = i * G + c; if (L >= 512) return false; u.pm = L >> 7; u.pn = L; return true; }
};

template <class Epi, class Sched, bool ALIGN_EPI = true, bool SP2 = true>
__device__ __forceinline__ void gemm_phase(LAS unsigned char* lds, const Gemm g, const Sched& S, const Epi& E) {
    int tid = threadIdx.x; asm volatile("" : "+v"(tid));
    const int wid = __builtin_amdgcn_readfirstlane(tid >> 6), lane = tid & 63, wr = wid >> 2, wc = wid & 3, fr = lane & 15, fq = lane >> 4;
    const int nt = g.K / BK;
    unsigned voffA[2], voffB[2];
#pragma unroll
    for (int i = 0; i < 2; ++i) { int R, C; stage_rc(tid * 16 + i * 8192, R, C); const int Rb = Epi::PERM ? ((R & ~31) + perm32(R & 31)) : R;
        voffA[i] = (unsigned)(R * g.lda + C) * 2u; voffB[i] = (unsigned)(Rb * g.ldb + C) * 2u; }
    const size_t kstep = (size_t)(BK * 2);
    const size_t hstepA = (size_t)HALF * g.lda * 2, hstepB = (size_t)HALF * g.ldb * 2;
    const size_t tstepA = 2 * hstepA, tstepB = 2 * hstepB;
    const unsigned ldsw = (unsigned)wid * 1024u;
    const int aoff = lds_byte(wr * 64 + fr, fq * 8), boff = lds_byte(wc * 32 + fr, fq * 8);
#define PG8_SA(b, h) (((b) * 2 + (h)) * HTB)
#define PG8_SB(b, h) ((4 + (b) * 2 + (h)) * HTB)
#define PG8_STAGE(bufoff, gbase, voff) do { _Pragma("unroll") for (int _i = 0; _i < 2; ++_i) \
        __builtin_amdgcn_global_load_lds((const unsigned*)((const char*)(gbase) + (voff)[_i]), (LAS unsigned*)(lds + (bufoff) + ldsw + _i * 8192), 16, 0, 0); } while (0)
#define PG8_LDA(dst, b, h) do { _Pragma("unroll") for (int m = 0; m < 4; ++m) _Pragma("unroll") for (int k = 0; k < 2; ++k) dst[m][k] = *(const LAS bf16x8*)(lds + PG8_SA(b, h) + aoff + m * 2048 + k * 1024); } while (0)
#define PG8_LDB(dst, b, h) do { _Pragma("unroll") for (int n = 0; n < 2; ++n) _Pragma("unroll") for (int k = 0; k < 2; ++k) dst[n][k] = *(const LAS bf16x8*)(lds + PG8_SB(b, h) + boff + n * 2048 + k * 1024); } while (0)
#define PG8_MMA(ai, bj, At, Bt) do { __builtin_amdgcn_s_setprio(1); _Pragma("unroll") for (int m = 0; m < 4; ++m) _Pragma("unroll") for (int n = 0; n < 2; ++n) _Pragma("unroll") for (int k = 0; k < 2; ++k) \
        acc[ai][bj][m][n] = __builtin_amdgcn_mfma_f32_16x16x32_bf16(Bt[n][k], At[m][k], acc[ai][bj][m][n], 0, 0, 0); __builtin_amdgcn_s_setprio(0); } while (0)
#define PG8_WAIT_V(n) asm volatile("s_waitcnt vmcnt(" #n ")" ::: "memory")
#define PG8_WAIT_L(n) asm volatile("s_waitcnt lgkmcnt(" #n ")" ::: "memory")
#define PG8_BAR __builtin_amdgcn_s_barrier()
#define PG8_SCHED __builtin_amdgcn_sched_barrier(0)
    Unit cur, nxt; int ui = 0;
    if (!S.next(0, cur)) return;
    cur.par = 0;
    f32x4 acc[2][2][4][2];
#pragma unroll
    for (int a = 0; a < 2; ++a)
#pragma unroll
        for (int b = 0; b < 2; ++b)
#pragma unroll
            for (int m = 0; m < 4; ++m)
#pragma unroll
                for (int n = 0; n < 2; ++n) acc[a][b][m][n] = (f32x4){0.f, 0.f, 0.f, 0.f};
    bf16x8 At[4][2], B0[2][2], B1[2][2];
    const char* cA = (const char*)g.A + (size_t)cur.pm * tstepA; const char* cB = (const char*)g.Bt + (size_t)cur.pn * tstepB;
    const size_t ko0 = (size_t)g.koff * kstep, kend = (size_t)nt * kstep;
    if constexpr (SP2) {
        PG8_STAGE(PG8_SB(0, 0), cB + ko0, voffB); PG8_STAGE(PG8_SB(0, 1), cB + ko0 + hstepB, voffB); PG8_STAGE(PG8_SA(0, 0), cA + ko0, voffA); PG8_STAGE(PG8_SA(0, 1), cA + ko0 + hstepA, voffA);
        if (wr == 1) PG8_BAR;
        PG8_WAIT_V(2); PG8_BAR;
        PG8_STAGE(PG8_SB(1, 0), cB + ko0 + kstep, voffB); PG8_STAGE(PG8_SA(1, 0), cA + ko0 + kstep, voffA); PG8_STAGE(PG8_SB(1, 1), cB + ko0 + hstepB + kstep, voffB);
        PG8_WAIT_V(6); PG8_BAR;
    } else {
        PG8_STAGE(PG8_SB(0, 0), cB, voffB); PG8_STAGE(PG8_SA(0, 0), cA, voffA); PG8_STAGE(PG8_SB(0, 1), cB + hstepB, voffB); PG8_STAGE(PG8_SA(0, 1), cA + hstepA, voffA);
        if (wr == 1) PG8_BAR;
        PG8_WAIT_V(4); PG8_BAR;
        PG8_STAGE(PG8_SB(1, 0), cB + kstep, voffB); PG8_STAGE(PG8_SA(1, 0), cA + kstep, voffA); PG8_STAGE(PG8_SB(1, 1), cB + hstepB + kstep, voffB);
        PG8_WAIT_V(6); PG8_BAR;
    }
    for (;;) {
        const bool has_next = S.next(ui + 1, nxt); nxt.par = (ui + 1) & 1;
        const char* nA = has_next ? (const char*)g.A + (size_t)nxt.pm * tstepA : cA; const char* nB = has_next ? (const char*)g.Bt + (size_t)nxt.pn * tstepB : cB;
        if constexpr (Epi::PRE) E.stage_pre(cur, lds, wid, lane);
        size_t ko = ko0;
        int unt = nt; if constexpr (Sched::VARK) unt = cur.nt;
        for (int t = 0; t < unt; t += 2) {
            const bool last = (t == unt - 2);
            size_t kn = ko + 2 * kstep; if (kn >= kend) kn -= kend;
            const char* a1 = cA + ko + kstep;
            const char* a2 = last ? nA + ko0 : cA + kn; const char* b2 = last ? nB + ko0 : cB + kn;
            const char* a3 = a2 + kstep; const char* b3 = b2 + kstep;
            ko = kn;
            if constexpr (SP2) {
            PG8_LDB(B0, 0, 0); PG8_LDB(B1, 0, 1); PG8_SCHED; PG8_LDA(At, 0, 0); PG8_STAGE(PG8_SA(1, 1), a1 + hstepA, voffA);
            PG8_WAIT_V(8); PG8_WAIT_L(0); PG8_BAR; PG8_MMA(0, 0, At, B0); PG8_MMA(0, 1, At, B1); PG8_BAR; PG8_SCHED;
            PG8_LDA(At, 0, 1); PG8_STAGE(PG8_SB(0, 0), b2, voffB); PG8_STAGE(PG8_SB(0, 1), b2 + hstepB, voffB); PG8_STAGE(PG8_SA(0, 0), a2, voffA);
            PG8_WAIT_V(8); PG8_WAIT_L(0); PG8_BAR; PG8_MMA(1, 0, At, B0); PG8_MMA(1, 1, At, B1); PG8_BAR; PG8_SCHED;
            PG8_LDB(B0, 1, 0); PG8_LDB(B1, 1, 1); PG8_SCHED; PG8_LDA(At, 1, 0); PG8_STAGE(PG8_SA(0, 1), a2 + hstepA, voffA);
            PG8_WAIT_V(8); PG8_WAIT_L(0); PG8_BAR; PG8_MMA(0, 0, At, B0); PG8_MMA(0, 1, At, B1); PG8_BAR; PG8_SCHED;
            PG8_LDA(At, 1, 1); PG8_STAGE(PG8_SB(1, 0), b3, voffB); PG8_STAGE(PG8_SB(1, 1), b3 + hstepB, voffB); PG8_STAGE(PG8_SA(1, 0), a3, voffA);
            PG8_WAIT_V(8); PG8_WAIT_L(0); PG8_BAR; PG8_MMA(1, 0, At, B0); PG8_MMA(1, 1, At, B1); PG8_BAR; PG8_SCHED;
            } else {
            PG8_LDB(B0, 0, 0); PG8_SCHED; PG8_LDA(At, 0, 0); PG8_STAGE(PG8_SA(1, 1), a1 + hstepA, voffA);
            PG8_WAIT_L(8); PG8_BAR; PG8_WAIT_L(0); PG8_MMA(0, 0, At, B0); PG8_BAR; PG8_SCHED;
            PG8_LDB(B1, 0, 1); PG8_STAGE(PG8_SB(0, 0), b2, voffB);
            PG8_BAR; PG8_WAIT_L(0); PG8_MMA(0, 1, At, B1); PG8_BAR;
            PG8_LDA(At, 0, 1); PG8_STAGE(PG8_SA(0, 0), a2, voffA);
            PG8_BAR; PG8_WAIT_L(0); PG8_MMA(1, 0, At, B0); PG8_BAR; PG8_SCHED;
            PG8_STAGE(PG8_SB(0, 1), b2 + hstepB, voffB);
            PG8_WAIT_V(6); PG8_BAR; PG8_MMA(1, 1, At, B1); PG8_BAR;
            PG8_LDB(B0, 1, 0); PG8_SCHED; PG8_LDA(At, 1, 0); PG8_STAGE(PG8_SA(0, 1), a2 + hstepA, voffA);
            PG8_WAIT_L(8); PG8_BAR; PG8_WAIT_L(0); PG8_MMA(0, 0, At, B0); PG8_BAR; PG8_SCHED;
            PG8_LDB(B1, 1, 1); PG8_STAGE(PG8_SB(1, 0), b3, voffB);
            PG8_BAR; PG8_WAIT_L(0); PG8_MMA(0, 1, At, B1); PG8_BAR;
            PG8_LDA(At, 1, 1); PG8_STAGE(PG8_SA(1, 0), a3, voffA);
            PG8_BAR; PG8_WAIT_L(0); PG8_MMA(1, 0, At, B0); PG8_BAR; PG8_SCHED;
            PG8_STAGE(PG8_SB(1, 1), b3 + hstepB, voffB);
            PG8_WAIT_V(6); PG8_BAR; PG8_MMA(1, 1, At, B1); PG8_BAR;
            }
        }
        if constexpr (ALIGN_EPI) { if (wr == 0) PG8_BAR; }
        if constexpr (!Epi::AFTER_DRAIN) { E(acc, cur, wr, wc, fr, fq); }
        if (!has_next) break;
#pragma unroll
        for (int a = 0; a < 2; ++a)
#pragma unroll
            for (int b = 0; b < 2; ++b)
#pragma unroll
                for (int m = 0; m < 4; ++m)
#pragma unroll
                    for (int n = 0; n < 2; ++n) acc[a][b][m][n] = (f32x4){0.f, 0.f, 0.f, 0.f};
        cur = nxt; cA = nA; cB = nB; ++ui;
        if constexpr (ALIGN_EPI) { if (wr == 1) PG8_BAR; }
    }
    PG8_WAIT_V(0);
    if constexpr (!ALIGN_EPI) { if (wr == 0) PG8_BAR; }
    PG8_BAR;
    if constexpr (Epi::AFTER_DRAIN) { E.fused(acc, cur, wr, wc, fr, fq, lds, wid, lane); }
#undef PG8_SA
#undef PG8_SB
#undef PG8_STAGE
#undef PG8_LDA
#undef PG8_LDB
#undef PG8_MMA
#undef PG8_WAIT_V
#undef PG8_WAIT_L
#undef PG8_BAR
#undef PG8_SCHED
}
}
using pg8::Unit;
typedef f32x4 AccT[2][2][4][2];


__device__ __forceinline__ void stage_ssq(const float* ssq, int pm, int par, LAS unsigned char* lds, int wid, int lane) {
    if (wid < 4) __builtin_amdgcn_global_load_lds((const unsigned*)(ssq + (size_t)(pm * 256 + wid * 64 + lane) * 4), (LAS unsigned*)(lds + LDS_SPARE + par * 4096 + wid * 1024), 16, 0, 0);
}
__device__ __forceinline__ float rstd_from_lds(LAS unsigned char* lds, int par, int rl) {
    const f32x4 a = *(const LAS f32x4*)(lds + LDS_SPARE + par * 4096 + rl * 16);
    return __builtin_amdgcn_rsqf(((a.x + a.y) + (a.z + a.w)) * (1.0f / 1024.0f) + EPS);
}
__device__ __forceinline__ f32x2 sigmoid2(f32x2 z) { const f32x2 t = z * -1.44269504f; f32x2 e; e.x = __builtin_amdgcn_exp2f(t.x); e.y = __builtin_amdgcn_exp2f(t.y); e = e + 1.0f; f32x2 r; r.x = __builtin_amdgcn_rcpf(e.x); r.y = __builtin_amdgcn_rcpf(e.y); return r; }
__device__ __forceinline__ f32x2 gelu2(f32x2 x) { const f32x2 z = (x * x * 0.044715f + 1.0f) * x * 1.5957691216f; return x * sigmoid2(z); }
struct EpiSwiglu {
    static constexpr bool PERM = true, AFTER_DRAIN = false, PRE = true;
    bf16_t* H; const float* ssq; LAS unsigned char* lds;
    __device__ __forceinline__ void stage_pre(const Unit& u, LAS unsigned char* l, int wid, int lane) const { stage_ssq(ssq, u.pm, u.par, l, wid, lane); }
    __device__ __forceinline__ void operator()(const AccT& acc, const Unit& u, int wr, int wc, int fr, int fq) const {
        const int rl0 = wr * 64 + fr, row0 = u.pm * 256 + rl0, col0 = u.pn * 128 + wc * 32 + 8 * fq;
        float rsv[8];
#pragma unroll
        for (int i = 0; i < 8; ++i) rsv[i] = rstd_from_lds(lds, u.par, rl0 + (i >> 2) * 128 + (i & 3) * 16);
#pragma unroll
        for (int ai = 0; ai < 2; ++ai)
#pragma unroll
            for (int m = 0; m < 4; ++m) {
                if (m == 0 && ai == 1) __builtin_amdgcn_sched_barrier(0);
                const int row = row0 + ai * 128 + m * 16;
                const float r = rsv[ai * 4 + m];
                unsigned w[4];
#pragma unroll
                for (int n = 0; n < 2; ++n)
#pragma unroll
                    for (int j = 0; j < 4; j += 2) {
                        const f32x2 g = (f32x2){acc[ai][0][m][n][j], acc[ai][0][m][n][j + 1]} * r, uu = (f32x2){acc[ai][1][m][n][j], acc[ai][1][m][n][j + 1]} * r;
                        const f32x2 h = g * uu * sigmoid2(g);
                        w[n * 2 + (j >> 1)] = cvt_pk_bf16(h.x, h.y);
                    }
                u32x4 wv; wv.x = w[0]; wv.y = w[1]; wv.z = w[2]; wv.w = w[3];
                *(u32x4*)(H + (size_t)row * DFF + col0) = wv;
            }
    }
};
struct EpiResid {
    static constexpr bool PERM = true, AFTER_DRAIN = false, PRE = false;
    bf16_t* xb; float* ssq; float alpha; LAS float* sp;
    __device__ __forceinline__ void operator()(const AccT& acc, const Unit& u, int wr, int wc, int fr, int fq) const {
        const int rl0 = wr * 64 + fr, row0 = u.pm * 256 + rl0, col0 = u.pn * 256 + wc * 32 + 8 * fq, ln = fr + 16 * fq;
        u32x4 xo[2][4][2];
#pragma unroll
        for (int ai = 0; ai < 2; ++ai)
#pragma unroll
            for (int m = 0; m < 4; ++m)
#pragma unroll
                for (int bj = 0; bj < 2; ++bj) xo[ai][m][bj] = *(const u32x4*)(xb + (size_t)(row0 + ai * 128 + m * 16) * DM + col0 + bj * 128);
        asm volatile("" ::: "memory");
#pragma unroll
        for (int ai = 0; ai < 2; ++ai) {
#pragma unroll
            for (int m = 0; m < 4; ++m) {
                float s = 0.f;
#pragma unroll
                for (int bj = 0; bj < 2; ++bj) {
                    const f32x4 a = acc[ai][bj][m][0], b = acc[ai][bj][m][1]; const u32x4 o = xo[ai][m][bj];
                    u32x4 w;
                    w.x = cvt_pk_bf16(bf_lo(o.x) + alpha * a.x, bf_hi(o.x) + alpha * a.y); w.y = cvt_pk_bf16(bf_lo(o.y) + alpha * a.z, bf_hi(o.y) + alpha * a.w);
                    w.z = cvt_pk_bf16(bf_lo(o.z) + alpha * b.x, bf_hi(o.z) + alpha * b.y); w.w = cvt_pk_bf16(bf_lo(o.w) + alpha * b.z, bf_hi(o.w) + alpha * b.w);
                    *(u32x4*)(xb + (size_t)(row0 + ai * 128 + m * 16) * DM + col0 + bj * 128) = w;
                    s += (bf_lo(w.x) * bf_lo(w.x) + bf_hi(w.x) * bf_hi(w.x)) + (bf_lo(w.y) * bf_lo(w.y) + bf_hi(w.y) * bf_hi(w.y))
                       + (bf_lo(w.z) * bf_lo(w.z) + bf_hi(w.z) * bf_hi(w.z)) + (bf_lo(w.w) * bf_lo(w.w) + bf_hi(w.w) * bf_hi(w.w));
                }
                s += shx(s, 16, ln); s += shx(s, 32, ln);
                if (fq == 0) sp[(ai * 128 + rl0 + m * 16) * 4 + wc] = s;
            }
        }
        asm volatile("s_waitcnt lgkmcnt(0)" ::: "memory"); __builtin_amdgcn_s_barrier(); asm volatile("" ::: "memory");
        const int t = wr * 256 + wc * 64 + ln;
        if (t < 256) { const f32x4 p = *(const LAS f32x4*)(sp + t * 4); ssq[(size_t)(u.pm * 256 + t) * 4 + u.pn] = (p.x + p.y) + (p.z + p.w); }
    }
};
struct EpiMixIn {
    static constexpr bool PERM = true, AFTER_DRAIN = false, PRE = true;
    bf16_t* Assm; bf16_t* gu; bf16_t* gv; const float* ssq; LAS unsigned char* lds;
    __device__ __forceinline__ void stage_pre(const Unit& u, LAS unsigned char* l, int wid, int lane) const { stage_ssq(ssq, u.pm, u.par, l, wid, lane); }
    __device__ __forceinline__ void operator()(const AccT& acc, const Unit& u, int wr, int wc, int fr, int fq) const {
        const int rl0 = wr * 64 + fr, row0 = u.pm * 256 + rl0, col0 = u.pn * 256 + wc * 32 + 8 * fq;
        float rsv[8];
#pragma unroll
        for (int i = 0; i < 8; ++i) rsv[i] = rstd_from_lds(lds, u.par, rl0 + (i >> 2) * 128 + (i & 3) * 16);
#pragma unroll
        for (int ai = 0; ai < 2; ++ai)
#pragma unroll
            for (int m = 0; m < 4; ++m) {
                if (m == 0) __builtin_amdgcn_sched_barrier(0);
                const int tok = row0 + ai * 128 + m * 16;
                const float rs = rsv[ai * 4 + m];
#pragma unroll
                for (int bj = 0; bj < 2; ++bj) {
                    const int j0 = col0 + bj * 128;
                    f32x2 v[4];
#pragma unroll
                    for (int n = 0; n < 2; ++n)
#pragma unroll
                        for (int j = 0; j < 2; ++j) v[n * 2 + j] = (f32x2){acc[ai][bj][m][n][2 * j], acc[ai][bj][m][n][2 * j + 1]} * rs;
                    bf16_t* dst;
                    if (u.pn < 2) {
                        const int g = j0 >> 4, c0 = j0 & 15, b = tok >> 11, l = tok & 2047;
                        dst = Assm + (size_t)(g * 1024 + b * 32 + (l >> 6)) * KSSM + 128 + (l & 63) * 16 + c0;
                    } else {
#pragma unroll
                        for (int j = 0; j < 4; ++j) v[j] = gelu2(v[j]);
                        dst = (u.pn < 4) ? gu + (size_t)tok * 512 + (j0 - 512) : gv + (size_t)tok * 512 + (j0 - 1024);
                    }
                    u32x4 w; w.x = cvt_pk_bf16(v[0].x, v[0].y); w.y = cvt_pk_bf16(v[1].x, v[1].y); w.z = cvt_pk_bf16(v[2].x, v[2].y); w.w = cvt_pk_bf16(v[3].x, v[3].y);
                    *(u32x4*)dst = w;
                }
            }
    }
};
struct EpiState {
    static constexpr bool PERM = false, AFTER_DRAIN = true, PRE = false;
    bf16_t* Assm; const float* are; const float* aim; const float* logdt;
    __device__ __forceinline__ void fused(const AccT& acc, const Unit& u, int wr, int wc, int fr, int fq, LAS unsigned char* lds, int wid, int lane) const {
        LAS float* T = (LAS float*)lds;
#pragma unroll
        for (int ai = 0; ai < 2; ++ai)
#pragma unroll
            for (int m = 0; m < 4; ++m)
#pragma unroll
                for (int n = 0; n < 2; ++n)
                    *(LAS f32x4*)(T + (ai * 128 + wr * 64 + m * 16 + fr) * 128 + wc * 32 + n * 16 + 4 * fq) = acc[ai][0][m][n];
        __syncthreads();
        const int g = u.pn, pml = u.pm & 3, bl = wid, p = lane;
        const float dt = __expf(logdt[g]);
        const f32x2 l64 = lam_pow(are[g * 64 + p], aim[g * 64 + p], dt, 64);
        float hr = 0.f, hi = 0.f;
        bf16_t* dst = Assm + (size_t)(g * 1024 + (8 * pml + bl) * 32) * KSSM + p;
        for (int ch = 0; ch < 32; ++ch) {
            dst[(size_t)ch * KSSM] = (bf16_t)(cvt_pk_bf16(hr, hr) & 0xffffu);
            dst[(size_t)ch * KSSM + 64] = (bf16_t)(cvt_pk_bf16(hi, hi) & 0xffffu);
            const float sr = T[(bl * 32 + ch) * 128 + p], si = T[(bl * 32 + ch) * 128 + 64 + p];
            const float nr = l64.x * hr - l64.y * hi + sr, ni = l64.x * hi + l64.y * hr + si;
            hr = nr; hi = ni;
        }
    }
};
struct EpiSsmY {
    static constexpr bool PERM = true, AFTER_DRAIN = false, PRE = false;
    bf16_t* yraw;
    __device__ __forceinline__ void operator()(const AccT& acc, const Unit& u, int wr, int wc, int fr, int fq) const {
        const int g = u.pn >> 2, pnl = u.pn & 3, pml = u.pm & 3;
#pragma unroll
        for (int ai = 0; ai < 2; ++ai)
#pragma unroll
            for (int m = 0; m < 4; ++m) {
                const int r = 256 * pml + 128 * ai + 64 * wr + 16 * m + fr;
#pragma unroll
                for (int bj = 0; bj < 2; ++bj) {
                    const int n0 = 256 * pnl + 128 * bj + 32 * wc + 8 * fq, tau = n0 >> 4, c0 = n0 & 15;
                    const f32x4 a = acc[ai][bj][m][0], b = acc[ai][bj][m][1];
                    u32x4 w; w.x = cvt_pk_bf16(a.x, a.y); w.y = cvt_pk_bf16(a.z, a.w); w.z = cvt_pk_bf16(b.x, b.y); w.w = cvt_pk_bf16(b.z, b.w);
                    *(u32x4*)(yraw + (size_t)(r * 64 + tau) * 512 + g * 16 + c0) = w;
                }
            }
    }
};
struct EpiGm {
    static constexpr bool PERM = true, AFTER_DRAIN = false, PRE = false;
    const bf16_t* gu; bf16_t* ygm; const float* vgain; const float* bs;
    __device__ __forceinline__ void operator()(const AccT& acc, const Unit& u, int wr, int wc, int fr, int fq) const {
        const int h = u.pm, q = u.pn & 127, d0 = 32 * wc + 8 * fq;
        const f32x4 g0 = *(const f32x4*)(vgain + h * 128 + d0), g1 = *(const f32x4*)(vgain + h * 128 + d0 + 4);
#pragma unroll
        for (int ai = 0; ai < 2; ++ai) {
            u32x4 uu[4][2]; float bb[4];
#pragma unroll
            for (int m = 0; m < 4; ++m) {
                const int t2 = 128 * ai + 64 * wr + 16 * m + fr;
                bb[m] = bs[h * 128 + (t2 & 127)];
#pragma unroll
                for (int bj = 0; bj < 2; ++bj) uu[m][bj] = *(const u32x4*)(gu + (size_t)((2 * q + bj) * 256 + t2) * 512 + h * 128 + d0);
            }
            asm volatile("" ::: "memory");
#pragma unroll
            for (int m = 0; m < 4; ++m) {
                const int t2 = 128 * ai + 64 * wr + 16 * m + fr;
                const float b = bb[m];
#pragma unroll
                for (int bj = 0; bj < 2; ++bj) {
                    const size_t o = (size_t)((2 * q + bj) * 256 + t2) * 512 + h * 128 + d0;
                    const u32x4 x = uu[m][bj];
                    const f32x4 a = acc[ai][bj][m][0] * g0 + b, c = acc[ai][bj][m][1] * g1 + b;
                    u32x4 w;
                    w.x = cvt_pk_bf16(bf_lo(x.x) * a.x, bf_hi(x.x) * a.y); w.y = cvt_pk_bf16(bf_lo(x.y) * a.z, bf_hi(x.y) * a.w);
                    w.z = cvt_pk_bf16(bf_lo(x.z) * c.x, bf_hi(x.z) * c.y); w.w = cvt_pk_bf16(bf_lo(x.w) * c.z, bf_hi(x.w) * c.w);
                    *(u32x4*)(ygm + o) = w;
                }
            }
            asm volatile("" ::: "memory");
        }
    }
};

__device__ __forceinline__ void p0_transpose_item(const float* W, int K, int N, bf16_t* WT, const float* gain, bool swi, LAS float* scr, int item, int lane) {
    const int nblk = N / 32, kb = item / nblk, nb = item % nblk, k0 = 64 * kb, n0 = 32 * nb;
    int s0 = n0;
    if (swi) { const int pn = n0 >> 8, r = n0 & 255; s0 = (r < 128) ? (128 * pn + r) : (DFF + 128 * pn + (r - 128)); }
    float tv[32];
#pragma unroll
    for (int i = 0; i < 32; ++i) tv[i] = W[(size_t)(k0 + 2 * i + (lane >> 5)) * N + s0 + (lane & 31)];
    if (gain) {
#pragma unroll
        for (int i = 0; i < 32; ++i) tv[i] *= gain[k0 + 2 * i + (lane >> 5)];
    }
#pragma unroll
    for (int i = 0; i < 32; ++i) scr[(2 * i + (lane >> 5)) * 33 + (lane & 31)] = tv[i];
    asm volatile("s_waitcnt lgkmcnt(0)" ::: "memory");
    const int c = lane & 7;
#pragma unroll
    for (int j = 0; j < 4; ++j) { const int n = (lane >> 3) + 8 * j; const LAS float* s = scr + (8 * c) * 33 + n;
        u32x4 o; o.x = cvt_pk_bf16(s[0 * 33], s[1 * 33]); o.y = cvt_pk_bf16(s[2 * 33], s[3 * 33]); o.z = cvt_pk_bf16(s[4 * 33], s[5 * 33]); o.w = cvt_pk_bf16(s[6 * 33], s[7 * 33]);
        *(u32x4*)(WT + (size_t)(n0 + n) * K + k0 + 8 * c) = o; }
    asm volatile("s_waitcnt lgkmcnt(0)" ::: "memory");
}

__device__ __forceinline__ void p0_ssm_item(const Params& P, int zoff, int item, LAS unsigned char* lds) {
    int tid = threadIdx.x; asm volatile("" : "+v"(tid));
    const int l = item >> 7, g = (item >> 2) & 31, q = item & 3, lg = l * 32 + g;
    LAS float* lam_re = (LAS float*)lds;
    LAS float* lam_im = lam_re + 65 * 64;
    LAS float* be_re = lam_im + 65 * 64;
    LAS float* be_im = be_re + 1024;
    LAS float* c_re = be_im + 1024;
    LAS float* c_im = c_re + 1024;
    LAS float* kt = c_im + 1024;
    const float* a_re = P.in[6 + zoff] + lg * 64; const float* a_im = P.in[7 + zoff] + lg * 64;
    const float dt = __expf(P.in[8 + zoff][lg]);
    for (int idx = tid; idx < 65 * 64; idx += 512) { const int k = idx >> 6, p = idx & 63; const f32x2 v = lam_pow(a_re[p], a_im[p], dt, k); lam_re[idx] = v.x; lam_im[idx] = v.y; }
    __syncthreads();
    for (int idx = tid; idx < 1024; idx += 512) {
        const int p = idx >> 4, c = idx & 15;
        const float lr = lam_re[64 + p] - 1.0f, li = lam_im[64 + p], ar = a_re[p], ai = a_im[p], inv = 1.0f / (ar * ar + ai * ai);
        const float qr = (lr * ar + li * ai) * inv, qi = (li * ar - lr * ai) * inv;
        const float br = P.in[9 + zoff][(size_t)(lg * 64 + p) * 16 + c], bi = P.in[10 + zoff][(size_t)(lg * 64 + p) * 16 + c];
        be_re[idx] = qr * br - qi * bi; be_im[idx] = qr * bi + qi * br;
        c_re[idx] = P.in[11 + zoff][(size_t)lg * 1024 + idx]; c_im[idx] = P.in[12 + zoff][(size_t)lg * 1024 + idx];
    }
    __syncthreads();
    for (int pr = tid; pr < 1024; pr += 512) {
        const int k = pr >> 4, c = pr & 15;
        float a[16];
#pragma unroll
        for (int j = 0; j < 16; ++j) a[j] = 0.f;
        for (int p = 0; p < 64; ++p) {
            const float cr = c_re[c * 64 + p], ci = c_im[c * 64 + p], lr = lam_re[k * 64 + p], li = lam_im[k * 64 + p];
            const float xr = cr * lr - ci * li, xi = cr * li + ci * lr;
#pragma unroll
            for (int j4 = 0; j4 < 4; ++j4) {
                const f32x4 br = *(const LAS f32x4*)(be_re + p * 16 + j4 * 4), bi = *(const LAS f32x4*)(be_im + p * 16 + j4 * 4);
#pragma unroll
                for (int j = 0; j < 4; ++j) a[j4 * 4 + j] += xr * br[j] - xi * bi[j];
            }
        }
        if (k == 0) {
            const float dsk = P.in[13 + zoff][lg * 16 + c];
#pragma unroll
            for (int j = 0; j < 16; ++j) if (j == c) a[j] += dsk;
        }
#pragma unroll
        for (int j = 0; j < 16; ++j) kt[pr * 16 + j] = a[j];
    }
    __syncthreads();
    bf16_t* Bs = (bf16_t*)(P.ws + OFF_BSSM + (size_t)l * SZ_BSSM) + (size_t)g * 1024 * KSSM;
    const int nvec = 16 + 2 * 16 * (q + 1);
    for (int idx = tid; idx < 256 * nvec; idx += 512) {
        const int n = 256 * q + idx / nvec, v = idx % nvec, tau = n >> 4, c = n & 15;
        float o[8];
        if (v >= 16) {
            const int s = (v - 16) >> 1, c0 = ((v - 16) & 1) * 8;
            if (s <= tau) {
                const LAS float* src = kt + ((tau - s) * 16 + c) * 16 + c0;
#pragma unroll
                for (int j = 0; j < 8; ++j) o[j] = src[j];
            } else {
#pragma unroll
                for (int j = 0; j < 8; ++j) o[j] = 0.f;
            }
        } else {
            const int j0 = v * 8;
#pragma unroll
            for (int j = 0; j < 8; ++j) {
                const int p = (j0 + j) & 63;
                const float cr = c_re[c * 64 + p], ci = c_im[c * 64 + p], lr = lam_re[(tau + 1) * 64 + p], li = lam_im[(tau + 1) * 64 + p];
                o[j] = (j0 < 64) ? (cr * lr - ci * li) : -(cr * li + ci * lr);
            }
        }
        u32x4 w; w.x = cvt_pk_bf16(o[0], o[1]); w.y = cvt_pk_bf16(o[2], o[3]); w.z = cvt_pk_bf16(o[4], o[5]); w.w = cvt_pk_bf16(o[6], o[7]);
        *(u32x4*)(Bs + (size_t)n * KSSM + v * 8) = w;
    }
    bf16_t* Bt = (bf16_t*)(P.ws + OFF_BST + (size_t)l * SZ_BST) + (size_t)g * 256 * 1024;
    for (int idx = tid; idx < 64 * 128; idx += 512) {
        const int r = 64 * q + (idx >> 7), v = idx & 127, s = v >> 1, c0 = (v & 1) * 8;
        float o[8];
        if (r < 128) {
            const int p = r & 63;
            const float lr = lam_re[(63 - s) * 64 + p], li = lam_im[(63 - s) * 64 + p];
#pragma unroll
            for (int j = 0; j < 8; ++j) { const float br = be_re[p * 16 + c0 + j], bi = be_im[p * 16 + c0 + j]; o[j] = (r < 64) ? (lr * br - li * bi) : (lr * bi + li * br); }
        } else {
#pragma unroll
            for (int j = 0; j < 8; ++j) o[j] = 0.f;
        }
        u32x4 w; w.x = cvt_pk_bf16(o[0], o[1]); w.y = cvt_pk_bf16(o[2], o[3]); w.z = cvt_pk_bf16(o[4], o[5]); w.w = cvt_pk_bf16(o[6], o[7]);
        *(u32x4*)(Bt + (size_t)r * 1024 + v * 8) = w;
    }
    __syncthreads();
}

__device__ __forceinline__ void phase0(const Params& P, int zoff, LAS unsigned char* lds, int c, int G) {
    int tid = threadIdx.x; asm volatile("" : "+v"(tid));
    const int lane = tid & 63, wave = tid >> 6;
    const bool ssm_first = (((c >> 3) & 1) == 0);
    if (ssm_first) { for (int it = c; it < 256; it += G) p0_ssm_item(P, zoff, it, lds); }
    {
        LAS float* scr = (LAS float*)(lds + wave * 16384);
        const int gw = c * 8 + wave, NGW = G * 8;
        constexpr int I_IN = 16 * 176, I_OUT = 44 * 32, I_MI = 16 * 48, I_MO = 16 * 32, PER_LAYER = 2 * I_IN + 2 * I_OUT + I_MI + I_MO;
        for (int rp = 0; rp <= ((PROBE_P0 >> 1) & 1); ++rp)
        for (int it = gw; it < 2 * PER_LAYER; it += NGW) {
            const int l = it / PER_LAYER; int r = it % PER_LAYER;
            unsigned char* wb = P.ws + OFF_W + (size_t)l * W_LAYER;
            if (r < I_IN) { p0_transpose_item(P.in[2 + zoff] + (size_t)l * 1024 * 5632, 1024, 5632, (bf16_t*)(wb + W_IN1), P.in[1 + zoff] + l * 1024, true, scr, r, lane); continue; } r -= I_IN;
            if (r < I_OUT) { p0_transpose_item(P.in[3 + zoff] + (size_t)l * 2816 * 1024, 2816, 1024, (bf16_t*)(wb + W_OUT1), nullptr, false, scr, r, lane); continue; } r -= I_OUT;
            if (r < I_MI) { p0_transpose_item(P.in[5 + zoff] + (size_t)l * 1024 * 1536, 1024, 1536, (bf16_t*)(wb + W_MI), P.in[4 + zoff] + l * 1024, false, scr, r, lane); continue; } r -= I_MI;
            if (r < I_MO) { p0_transpose_item(P.in[21 + zoff] + (size_t)l * 1024 * 1024, 1024, 1024, (bf16_t*)(wb + W_MO), nullptr, false, scr, r, lane); continue; } r -= I_MO;
            if (r < I_IN) { p0_transpose_item(P.in[23 + zoff] + (size_t)l * 1024 * 5632, 1024, 5632, (bf16_t*)(wb + W_IN2), P.in[22 + zoff] + l * 1024, true, scr, r, lane); continue; } r -= I_IN;
            p0_transpose_item(P.in[24 + zoff] + (size_t)l * 2816 * 1024, 2816, 1024, (bf16_t*)(wb + W_OUT2), nullptr, false, scr, r, lane);
        }
    }
    {
        bf16_t* xb = (bf16_t*)(P.ws + OFF_XB); float* ssq = (float*)(P.ws + OFF_SSQ);
        for (int rp = 0; rp <= ((PROBE_P0 >> 2) & 1); ++rp)
        for (int row = c * 8 + wave; row < MTOK; row += G * 32) {
            f32x4 v[4][4];
#pragma unroll
            for (int r = 0; r < 4; ++r) {
                const f32x4* xr = (const f32x4*)(P.in[0 + zoff] + (size_t)(row + r * G * 8) * DM) + lane;
#pragma unroll
                for (int j = 0; j < 4; ++j) v[r][j] = xr[64 * j];
            }
#pragma unroll
            for (int r = 0; r < 4; ++r) {
                const int rw = row + r * G * 8;
                float s = 0.f;
#pragma unroll
                for (int j = 0; j < 4; ++j) s += (v[r][j].x * v[r][j].x + v[r][j].y * v[r][j].y) + (v[r][j].z * v[r][j].z + v[r][j].w * v[r][j].w);
                s = wave_sum(s, lane);
                u32x2* o8 = (u32x2*)(xb + (size_t)rw * DM) + lane;
#pragma unroll
                for (int j = 0; j < 4; ++j) { u32x2 w; w.x = cvt_pk_bf16(v[r][j].x, v[r][j].y); w.y = cvt_pk_bf16(v[r][j].z, v[r][j].w); o8[64 * j] = w; }
                if (lane < 4) ssq[(size_t)rw * 4 + lane] = (lane == 0) ? s : 0.f;
            }
        }
    }
    {
        for (int idx = (c * 512 + tid); idx < 2 * 4 * 256 * 32; idx += G * 512) {
            const int s8 = idx & 31, t2 = (idx >> 5) & 255, h = (idx >> 13) & 3, l = idx >> 15;
            const int t = t2 & 127, s0 = (s8 * 8) & 127;
            const bool same = ((s8 * 8) >> 7) == (t2 >> 7);
            const float* src = P.in[17 + zoff] + ((size_t)(l * 4 + h) * 128 + t) * 128 + s0;
            float o[8];
#pragma unroll
            for (int j = 0; j < 8; ++j) o[j] = (same && (s0 + j) <= t) ? src[j] : 0.f;
            u32x4 w; w.x = cvt_pk_bf16(o[0], o[1]); w.y = cvt_pk_bf16(o[2], o[3]); w.z = cvt_pk_bf16(o[4], o[5]); w.w = cvt_pk_bf16(o[6], o[7]);
            *(u32x4*)((bf16_t*)(P.ws + OFF_WEXP + (size_t)l * SZ_WEXP) + ((size_t)(h * 256 + t2) * 256 + s8 * 8)) = w;
        }
    }
    if (!ssm_first) { __syncthreads(); for (int it = c; it < 256; it += G) p0_ssm_item(P, zoff, it, lds); }
}

__device__ __forceinline__ void vfix_phase(unsigned char* ws, LAS unsigned char* lds, int c, int G) {
    int tid = threadIdx.x; asm volatile("" : "+v"(tid));
    const bf16_t* gv = (const bf16_t*)(ws + OFF_GV); bf16_t* VT = (bf16_t*)(ws + OFF_VT);
    LAS bf16_t* T = (LAS bf16_t*)lds;
    const bool bal = (G == 256);
    const int it_lo = bal ? (c < 128 ? 3 * c : 384 + 5 * (c - 128)) : c, it_n = bal ? (c < 128 ? 3 : 5) : (1024 - c + G - 1) / G, it_st = bal ? 1 : G;
    for (int ii = 0; ii < it_n; ++ii) {
        const int it = it_lo + ii * it_st;
        const int h = it & 3, bn = it >> 2;
        for (int pass = 0; pass < 8; ++pass) {
            const int row = pass * 32 + (tid >> 4), ch = tid & 15;
            const u32x4 w = *(const u32x4*)(gv + (size_t)(bn * 256 + row) * 512 + h * 128 + ch * 8);
            float v[8] = {bf_lo(w.x), bf_hi(w.x), bf_lo(w.y), bf_hi(w.y), bf_lo(w.z), bf_hi(w.z), bf_lo(w.w), bf_hi(w.w)};
            float s = 0.f;
#pragma unroll
            for (int j = 0; j < 8; ++j) s += v[j] * v[j];
            { const int ln = tid & 63; s += shx(s, 1, ln); s += shx(s, 2, ln); s += shx(s, 4, ln); s += shx(s, 8, ln); }
            const float rs = __builtin_amdgcn_rsqf(s * (1.0f / 128.0f) + EPS);
#pragma unroll
            for (int j = 0; j < 8; j += 2) { const unsigned pk = cvt_pk_bf16(v[j] * rs, v[j + 1] * rs); T[(ch * 8 + j) * 264 + row] = (bf16_t)(pk & 0xffffu); T[(ch * 8 + j + 1) * 264 + row] = (bf16_t)(pk >> 16); }
        }
        __syncthreads();
        bf16_t* dst = VT + (size_t)(h * 256 + bn) * 128 * 256;
        for (int idx = tid; idx < 128 * 32; idx += 512) {
            const int d = idx >> 5, sg = idx & 31;
            *(u32x4*)(dst + (size_t)d * 256 + sg * 8) = *(const LAS u32x4*)(T + d * 264 + sg * 8);
        }
        __syncthreads();
    }
}

typedef float f32x16 __attribute__((ext_vector_type(16)));
__device__ __forceinline__ void post_phase(const Params& P, int zoff, unsigned char* ws, int l, LAS unsigned char* lds, int c, int G) {
    int tid = threadIdx.x; asm volatile("" : "+v"(tid));
    const int lane = tid & 63, wave = tid >> 6, tl = lane & 31, kh = lane >> 5;
    const bf16_t* yraw = (const bf16_t*)(ws + OFF_YRAW); const bf16_t* ygm = (const bf16_t*)(ws + OFF_YGM); bf16_t* Y = (bf16_t*)(ws + OFF_Y);
    const float* gw = P.in[14 + zoff] + (size_t)l * 32 * 512; const float* gb = P.in[15 + zoff] + (size_t)l * 1024;
    const float* gs = P.in[19 + zoff] + l * 512; const float* gg = P.in[20 + zoff] + l * 512;
    LAS u32x4* Wl = (LAS u32x4*)lds;
    LAS float* Bl = (LAS float*)(lds + 32768);
    LAS float* Gl = Bl + 1024;
    for (int idx = tid; idx < 32 * 64; idx += 512) {
        const int g = idx >> 6, ln = idx & 63;
        const float* wp = gw + g * 512 + (8 * (ln >> 5)) * 32 + (ln & 31);
        u32x4 ap; ap.x = cvt_pk_bf16(wp[0], wp[32]); ap.y = cvt_pk_bf16(wp[64], wp[96]); ap.z = cvt_pk_bf16(wp[128], wp[160]); ap.w = cvt_pk_bf16(wp[192], wp[224]);
        Wl[idx] = ap;
    }
    for (int i = tid; i < 1024; i += 512) Bl[i] = gb[i];
    Gl[tid] = gs[tid];
    __syncthreads();
    for (int item = c; item < MTOK / 256; item += G) {
        const int tok = item * 256 + wave * 32 + tl;
        const bf16_t* yr = yraw + (size_t)tok * 512 + kh * 8;
        bf16_t* yo = Y + (size_t)tok * 1024 + 4 * kh;
        const bool gm_first = (((c >> 3) & 1) != 0);
        if (gm_first) {
            const f32x4 ga = *(const f32x4*)(gg + lane * 8), gbv = *(const f32x4*)(gg + lane * 8 + 4);
    #pragma unroll 1
            for (int r0 = 0; r0 < 32; r0 += 8) {
                u32x4 wv[8];
    #pragma unroll
                for (int j = 0; j < 8; ++j) wv[j] = *(const u32x4*)(ygm + (size_t)(item * 256 + wave * 32 + r0 + j) * 512 + lane * 8);
    #pragma unroll
                for (int j = 0; j < 8; ++j) {
                    const u32x4 w = wv[j];
                    float v[8] = {bf_lo(w.x), bf_hi(w.x), bf_lo(w.y), bf_hi(w.y), bf_lo(w.z), bf_hi(w.z), bf_lo(w.w), bf_hi(w.w)};
                    float s = 0.f;
    #pragma unroll
                    for (int k = 0; k < 8; ++k) s += v[k] * v[k];
                    s = wave_sum(s, lane);
                    const float r2 = __builtin_amdgcn_rsqf(s * (1.0f / 512.0f) + EPS);
                    u32x4 o; o.x = cvt_pk_bf16(v[0] * r2 * ga.x, v[1] * r2 * ga.y); o.y = cvt_pk_bf16(v[2] * r2 * ga.z, v[3] * r2 * ga.w);
                    o.z = cvt_pk_bf16(v[4] * r2 * gbv.x, v[5] * r2 * gbv.y); o.w = cvt_pk_bf16(v[6] * r2 * gbv.z, v[7] * r2 * gbv.w);
                    *(u32x4*)(Y + (size_t)(item * 256 + wave * 32 + r0 + j) * 1024 + 512 + lane * 8) = o;
                }
            }
        }
        float ss = 0.f, rs = 0.f;
#pragma unroll 1
        for (int pass = 0; pass < 2; ++pass) {
#pragma unroll 1
            for (int g8 = 0; g8 < 32; g8 += 8) {
                u32x4 yv[8];
#pragma unroll
                for (int j = 0; j < 8; ++j) yv[j] = *(const u32x4*)(yr + (g8 + j) * 16);
#pragma unroll
                for (int j = 0; j < 8; ++j) {
                    const int g = g8 + j;
                    u32x4 ap = Wl[g * 64 + lane];
                    u32x4 bp;
                    bp.x = cvt_pk_bf16(gelu_tanh(bf_lo(yv[j].x)), gelu_tanh(bf_hi(yv[j].x))); bp.y = cvt_pk_bf16(gelu_tanh(bf_lo(yv[j].y)), gelu_tanh(bf_hi(yv[j].y)));
                    bp.z = cvt_pk_bf16(gelu_tanh(bf_lo(yv[j].z)), gelu_tanh(bf_hi(yv[j].z))); bp.w = cvt_pk_bf16(gelu_tanh(bf_lo(yv[j].w)), gelu_tanh(bf_hi(yv[j].w)));
                    f32x16 acc;
#pragma unroll
                    for (int q = 0; q < 4; ++q) { const f32x4 bv = *(const LAS f32x4*)(Bl + g * 32 + 8 * q + 4 * kh); acc[4 * q] = bv.x; acc[4 * q + 1] = bv.y; acc[4 * q + 2] = bv.z; acc[4 * q + 3] = bv.w; }
                    asm volatile("s_nop 4" : "+v"(ap), "+v"(bp));
                    acc = __builtin_amdgcn_mfma_f32_32x32x16_bf16(__builtin_bit_cast(bf16x8, ap), __builtin_bit_cast(bf16x8, bp), acc, 0, 0, 0);
                    u32x2 wq[2];
#pragma unroll
                    for (int q = 0; q < 2; ++q) {
                        float o[4];
#pragma unroll
                        for (int r = 0; r < 4; ++r) o[r] = acc[4 * q + r] * fast_sigmoid(acc[4 * (q + 2) + r]);
                        wq[q].x = cvt_pk_bf16(o[0], o[1]); wq[q].y = cvt_pk_bf16(o[2], o[3]);
                    }
                    if (pass == 0) {
#pragma unroll
                        for (int q = 0; q < 2; ++q) ss += (bf_lo(wq[q].x) * bf_lo(wq[q].x) + bf_hi(wq[q].x) * bf_hi(wq[q].x)) + (bf_lo(wq[q].y) * bf_lo(wq[q].y) + bf_hi(wq[q].y) * bf_hi(wq[q].y));
                    } else {
                        u32x2 ov[2];
#pragma unroll
                        for (int q = 0; q < 2; ++q) {
                            const f32x4 gn = *(const LAS f32x4*)(Gl + g * 16 + 8 * q + 4 * kh);
                            ov[q].x = cvt_pk_bf16(bf_lo(wq[q].x) * rs * gn.x, bf_hi(wq[q].x) * rs * gn.y); ov[q].y = cvt_pk_bf16(bf_lo(wq[q].y) * rs * gn.z, bf_hi(wq[q].y) * rs * gn.w);
                        }
                        const u32x2 snd = kh ? ov[0] : ov[1];
                        u32x2 rcv;
                        rcv.x = (unsigned)__builtin_amdgcn_ds_bpermute((lane ^ 32) << 2, (int)snd.x); rcv.y = (unsigned)__builtin_amdgcn_ds_bpermute((lane ^ 32) << 2, (int)snd.y);
                        u32x4 st;
                        if (kh) { st.x = rcv.x; st.y = rcv.y; st.z = ov[1].x; st.w = ov[1].y; } else { st.x = ov[0].x; st.y = ov[0].y; st.z = rcv.x; st.w = rcv.y; }
                        *(u32x4*)(Y + (size_t)tok * 1024 + g * 16 + 8 * kh) = st;
                    }
                }
            }
            if (pass == 0) { ss += shx(ss, 32, lane); rs = __builtin_amdgcn_rsqf(ss * (1.0f / 512.0f) + EPS); }
        }
        if (!gm_first) {
            const f32x4 ga = *(const f32x4*)(gg + lane * 8), gbv = *(const f32x4*)(gg + lane * 8 + 4);
    #pragma unroll 1
            for (int r0 = 0; r0 < 32; r0 += 8) {
                u32x4 wv[8];
    #pragma unroll
                for (int j = 0; j < 8; ++j) wv[j] = *(const u32x4*)(ygm + (size_t)(item * 256 + wave * 32 + r0 + j) * 512 + lane * 8);
    #pragma unroll
                for (int j = 0; j < 8; ++j) {
                    const u32x4 w = wv[j];
                    float v[8] = {bf_lo(w.x), bf_hi(w.x), bf_lo(w.y), bf_hi(w.y), bf_lo(w.z), bf_hi(w.z), bf_lo(w.w), bf_hi(w.w)};
                    float s = 0.f;
    #pragma unroll
                    for (int k = 0; k < 8; ++k) s += v[k] * v[k];
                    s = wave_sum(s, lane);
                    const float r2 = __builtin_amdgcn_rsqf(s * (1.0f / 512.0f) + EPS);
                    u32x4 o; o.x = cvt_pk_bf16(v[0] * r2 * ga.x, v[1] * r2 * ga.y); o.y = cvt_pk_bf16(v[2] * r2 * ga.z, v[3] * r2 * ga.w);
                    o.z = cvt_pk_bf16(v[4] * r2 * gbv.x, v[5] * r2 * gbv.y); o.w = cvt_pk_bf16(v[6] * r2 * gbv.z, v[7] * r2 * gbv.w);
                    *(u32x4*)(Y + (size_t)(item * 256 + wave * 32 + r0 + j) * 1024 + 512 + lane * 8) = o;
                }
            }
        }
    }
    __syncthreads();
}

__device__ __forceinline__ void final_phase(const Params& P, int zoff, unsigned char* ws, int c, int G) {
    int tid = threadIdx.x; asm volatile("" : "+v"(tid));
    const int lane = tid & 63, wave = tid >> 6;
    const bf16_t* xb = (const bf16_t*)(ws + OFF_XB);
    const float* gn = P.in[25 + zoff];
    const f32x4 g0 = *(const f32x4*)(gn + lane * 8), g1 = *(const f32x4*)(gn + lane * 8 + 4), g2 = *(const f32x4*)(gn + 512 + lane * 8), g3 = *(const f32x4*)(gn + 512 + lane * 8 + 4);
    for (int row = c * 8 + wave; row < MTOK; row += G * 32) {
        u32x4 av[4], bv[4];
#pragma unroll
        for (int r = 0; r < 4; ++r) { const bf16_t* xp = xb + (size_t)(row + r * G * 8) * DM + lane * 8; av[r] = *(const u32x4*)xp; bv[r] = *(const u32x4*)(xp + 512); }
#pragma unroll
        for (int r = 0; r < 4; ++r) {
            const u32x4 a = av[r], b = bv[r];
            const f32x4 v0 = {bf_lo(a.x), bf_hi(a.x), bf_lo(a.y), bf_hi(a.y)}, v1 = {bf_lo(a.z), bf_hi(a.z), bf_lo(a.w), bf_hi(a.w)};
            const f32x4 v2 = {bf_lo(b.x), bf_hi(b.x), bf_lo(b.y), bf_hi(b.y)}, v3 = {bf_lo(b.z), bf_hi(b.z), bf_lo(b.w), bf_hi(b.w)};
            float s = (v0.x * v0.x + v0.y * v0.y) + (v0.z * v0.z + v0.w * v0.w) + (v1.x * v1.x + v1.y * v1.y) + (v1.z * v1.z + v1.w * v1.w)
                    + (v2.x * v2.x + v2.y * v2.y) + (v2.z * v2.z + v2.w * v2.w) + (v3.x * v3.x + v3.y * v3.y) + (v3.z * v3.z + v3.w * v3.w);
            s = wave_sum(s, lane);
            const float rs = __builtin_amdgcn_rsqf(s * (1.0f / 1024.0f) + EPS);
            float* o = P.out + (size_t)(row + r * G * 8) * DM + lane * 8;
            *(f32x4*)o = v0 * rs * g0; *(f32x4*)(o + 4) = v1 * rs * g1; *(f32x4*)(o + 512) = v2 * rs * g2; *(f32x4*)(o + 516) = v3 * rs * g3;
        }
    }
}

#ifndef MK_MSPLIT
#define MK_MSPLIT 1
#endif
constexpr int NSTEP = MK_MSPLIT ? 13 : 9;
constexpr int N_PHASES = 1 + 2 * NSTEP + 1;

__global__ void __launch_bounds__(512, 2) mk_fwd(Params P) {
    extern __shared__ __attribute__((aligned(16))) unsigned char shm[];
    LAS unsigned char* lds = (LAS unsigned char*)shm;
    if (threadIdx.x < 4) ((LAS unsigned*)(lds + LDS_BARW))[threadIdx.x] = 0u;
    if (threadIdx.x == 0) {
        unsigned* bar0 = (unsigned*)(P.ws + OFF_BAR); const unsigned x = xb_xcc_id();
        (void)xb_add(&bar0[XB_XCNT(x)], 1u);
#if MK_VCU
        const unsigned rk = xb_add(&bar0[XB_VC(x & 7u)], 1u);
        ((LAS unsigned*)(lds + LDS_BARW))[2] = rk * 8u + (x & 7u);
#endif
    }
    __syncthreads();
    for (int ph = P.ph_lo; ph < P.ph_hi; ++ph) {
        int kind = 7;
        int s = 0, l = 0, half = 0, nhalf = 1;
        if (ph == 0) kind = 0; else if (ph < N_PHASES - 1) {
            l = (ph - 1) / NSTEP; const int s_ = (ph - 1) % NSTEP;
            if (MK_MSPLIT) {
                nhalf = 2;
                if (s_ < 4) { s = s_ & 1; half = s_ >> 1; } else if (s_ < 9) { s = s_ - 2; } else { s = 7 + ((s_ - 9) & 1); half = (s_ - 9) >> 1; }
            } else s = s_;
            kind = (s == 0 || s == 7) ? 1 : (s == 2) ? 2 : (s == 3) ? 3 : (s == 4) ? 4 : (s == 5) ? 5 : 6; }
        const int reps = 1 + ((PROBE_DUP >> kind) & 1);
        for (int rep = 0; rep < reps; ++rep) {
        unsigned char* ws = P.ws; int zoff = 0, c = blockIdx.x, G = gridDim.x;
#if MK_VCU
        if (ph > 0 && G == 256) {
            unsigned* bar0 = (unsigned*)(ws + OFF_BAR); bool ok = true;
#pragma unroll
            for (int j = 0; j < 8; ++j) ok = ok && (xb_ld(&bar0[XB_VC(j)]) == 32u);
            if (ok) c = (int)__builtin_amdgcn_readfirstlane(((volatile LAS unsigned*)(lds + LDS_BARW))[2]);
        }
#endif
        asm volatile("" : "+s"(ws), "+s"(zoff), "+s"(c), "+s"(G));
        bf16_t* xb = (bf16_t*)(ws + OFF_XB); bf16_t* hid = (bf16_t*)(ws + OFF_HID); float* ssq = (float*)(ws + OFF_SSQ);
        const int kro = MK_KROT ? ((((c >> 3) >> 3) * 4 + ((c >> 3) & 7) * 2)) : 0;
        bf16_t* Assm = (bf16_t*)(ws + OFF_ASSM); bf16_t* gu = (bf16_t*)(ws + OFF_GU); bf16_t* gv = (bf16_t*)(ws + OFF_GV);
        bf16_t* VT = (bf16_t*)(ws + OFF_VT); bf16_t* yraw = (bf16_t*)(ws + OFF_YRAW); bf16_t* Y = (bf16_t*)(ws + OFF_Y); bf16_t* ygm = (bf16_t*)(ws + OFF_YGM);
        if (ph == 0) {
#if (MK_MASK & 1)
            phase0(P, zoff, lds, c, G);
#endif
        } else if (ph == N_PHASES - 1) {
#if (MK_MASK & 2)
            final_phase(P, zoff, ws, c, G);
#endif
        } else {
            const unsigned char* wb = ws + OFF_W + (size_t)l * W_LAYER;
            if (s == 0 || s == 7) {
#if (MK_MASK & 4)
                pg8::Gemm g{xb, (const bf16_t*)(wb + (s == 0 ? W_IN1 : W_IN2)), DM, DM, DM, kro % 16};
                const int isE1split = MK_MSPLIT ? 1 : 0; const size_t r0 = (size_t)half * (MTOK / 2) * isE1split; const int mrows = isE1split ? MTOK / 2 : MTOK;
                g.A = xb + r0 * DM;
                pg8::StaticOrder S; S.init(mrows, 2 * DFF, G, c);
                EpiSwiglu E{hid + r0 * DFF, ssq + r0 * 4, lds};
                pg8::gemm_phase(lds, g, S, E);
#if PROBE_E1VAR
                { __syncthreads(); pg8::OrderSame S2{G, c, 1, S}; EpiSwiglu E2{(bf16_t*)(ws + WS_END), ssq, lds}; pg8::Gemm g2 = g; int kk2 = (PROBE_E1VAR == 3) ? 512 : 1024; asm volatile("" : "+s"(kk2)); g2.K = kk2; pg8::gemm_phase(lds, g2, S2, E2); }
#endif
#endif
            } else if (s == 1 || s == 6 || s == 8) {
#if (MK_MASK & 8)
                pg8::Gemm g;
                if (s == 6) g = pg8::Gemm{Y, (const bf16_t*)(wb + W_MO), DM, DM, DM, kro % 16};
                else g = pg8::Gemm{hid, (const bf16_t*)(wb + (s == 1 ? W_OUT1 : W_OUT2)), DFF, DFF, DFF, kro % 44};
                const bool spl = MK_MSPLIT && s != 6; const size_t r0 = spl ? (size_t)half * (MTOK / 2) : 0; const int mrows = spl ? MTOK / 2 : MTOK;
                g.A = g.A + r0 * g.lda;
                pg8::StaticOrder S; S.init(mrows, DM, G, c, (spl && MK_E2REV) ? 15 : 0);
                EpiResid E{xb + r0 * DM, ssq + r0 * 4, rep ? 0.0f : ((s == 6) ? 1.0f : 0.5f), (LAS float*)(lds + LDS_SPARE)};
                pg8::gemm_phase(lds, g, S, E);
#endif
            } else if (s == 2) {
#if (MK_MASK & 16)
                pg8::Gemm g{xb, (const bf16_t*)(wb + W_MI), DM, DM, DM, kro % 16};
                pg8::StaticOrder S; S.init(MTOK, NIN, G, c);
                EpiMixIn E{Assm, gu, gv, ssq, lds};
                pg8::gemm_phase(lds, g, S, E);
#endif
            } else if (s == 3) {
#if (MK_MASK & 32)
                vfix_phase(ws, lds, c, G);
                pg8::Gemm g{Assm + 128, (const bf16_t*)(ws + OFF_BST + (size_t)l * SZ_BST), KSSM, 1024, 1024, 0};
                pg8::OrderState S{G, c};
                EpiState E{Assm, P.in[6 + zoff] + l * 2048, P.in[7 + zoff] + l * 2048, P.in[8 + zoff] + l * 32};
                pg8::gemm_phase<EpiState, pg8::OrderState, false, true>(lds, g, S, E);
                __syncthreads();
#endif
            } else if (s == 4) {
#if (MK_MASK & 64)
                {
                    pg8::Gemm g{Assm, (const bf16_t*)(ws + OFF_BSSM + (size_t)l * SZ_BSSM), KSSM, KSSM, KSSM, 0};
                    pg8::OrderSsm S{G, c};
                    EpiSsmY E{yraw};
                    pg8::gemm_phase(lds, g, S, E);
                }
#endif
#if (MK_MASK & 128)
                {
                    int kk = 256; asm volatile("" : "+s"(kk));
                    pg8::Gemm g{(const bf16_t*)(ws + OFF_WEXP + (size_t)l * SZ_WEXP), VT, 256, 256, kk, 0};
                    pg8::OrderGm S{G, c};
                    EpiGm E{gu, ygm, P.in[16 + zoff] + l * 512, P.in[18 + zoff] + l * 512};
                    pg8::gemm_phase(lds, g, S, E);
                }
#endif
            } else {
#if (MK_MASK & 256)
                post_phase(P, zoff, ws, l, lds, c, G);
#endif
            }
        }
        }
#if MK_COOP
        if (ph + 1 < P.ph_hi) {
            if (P.ph_hi > 4096) cg::this_grid().sync(); else xcd_barrier((unsigned*)(P.ws + OFF_BAR), (volatile LAS unsigned*)(lds + LDS_BARW)); }
#endif
    }
#if MK_COOP
    for (int i = 0; i < PROBE_SYNC; ++i) xcd_barrier((unsigned*)(P.ws + OFF_BAR), (volatile LAS unsigned*)(lds + LDS_BARW));
#endif
}

extern "C" void kernel_launch(void* const* d_in, const int* in_sizes, int n_in, void* d_out, int out_size, void* d_ws, size_t ws_size, hipStream_t stream) {
    static int grid = 0;
    if (grid == 0) {
        if (n_in != 26 || out_size != MTOK * DM || ws_size < WS_END) { fprintf(stderr, "kernel_launch: unexpected shapes (n_in %d, out %d, ws %zu, need %zu)\n", n_in, out_size, ws_size, (size_t)WS_END); grid = -1; return; }
        int dev = 0, cus = 0, per_cu = 0;
        hipGetDevice(&dev);
        hipDeviceGetAttribute(&cus, hipDeviceAttributeMultiprocessorCount, dev);
        if (hipFuncSetAttribute((const void*)mk_fwd, hipFuncAttributeMaxDynamicSharedMemorySize, LDS_BYTES) != hipSuccess) { fprintf(stderr, "kernel_launch: hipFuncSetAttribute failed\n"); grid = -1; return; }
        hipOccupancyMaxActiveBlocksPerMultiprocessor(&per_cu, (const void*)mk_fwd, 512, LDS_BYTES);
        if (per_cu < 1) { fprintf(stderr, "kernel_launch: occupancy query says %d\n", per_cu); per_cu = 1; }
        (void)hipGetLastError();
        grid = cus;
    }
    if (grid < 0) return;
    if (hipMemsetAsync((char*)d_ws + OFF_BAR, 0, SZ_BAR, stream) != hipSuccess) { fprintf(stderr, "kernel_launch: memset failed\n"); return; }
    Params p{};
    for (int i = 0; i < 26; ++i) p.in[i] = (const float*)d_in[i];
    p.out = (float*)d_out; p.ws = (unsigned char*)d_ws;
#if MK_COOP
    p.ph_lo = 0; p.ph_hi = N_PHASES;
    void* args[] = {&p};
    hipError_t e = hipLaunchCooperativeKernel((const void*)mk_fwd, dim3(grid), dim3(512), args, LDS_BYTES, stream);
    if (e != hipSuccess) fprintf(stderr, "cooperative launch failed: %s (grid %d)\n", hipGetErrorString(e), grid);
#else
    for (int ph = 0; ph < N_PHASES; ++ph) {
        p.ph_lo = ph; p.ph_hi = ph + 1;
        hipLaunchKernelGGL(mk_fwd, dim3(grid), dim3(512), LDS_BYTES, stream, p);
    }
#endif
}
```
